# Optimizing an MI355X kernel written in HIP

```python
import jax, jax.numpy as jnp
from jax import lax
import numpy as np

D_MODEL = 2048
BATCH = 8
SEQ = 4096
DEPTH = 4

MEM_TOKENS = 256
EPS = 1e-6
ROPE_THETA = 10000.0
Q_BLOCK = 128
MLA_HEADS = D_MODEL // 256
QK_NOPE_DIM = 128
QK_ROPE_DIM = 64
QK_HEAD_DIM = QK_NOPE_DIM + QK_ROPE_DIM
V_HEAD_DIM = 128
Q_LORA_RANK = D_MODEL // 4
KV_LORA_RANK = D_MODEL // 8
MLA_WIDTH = MLA_HEADS * V_HEAD_DIM
CONV_WIDTH = D_MODEL // 4
CONV_K = 3
MEM_HEADS = 4
MEM_HEAD_DIM = D_MODEL // 16
MEM_WIDTH = MEM_HEADS * MEM_HEAD_DIM
MIX_WIDTH = MLA_WIDTH + CONV_WIDTH + MEM_WIDTH
IN_SPLITS = (Q_LORA_RANK, KV_LORA_RANK, QK_ROPE_DIM, CONV_WIDTH, CONV_WIDTH, CONV_WIDTH, MEM_WIDTH, MIX_WIDTH)
IN_COLS = Q_LORA_RANK + KV_LORA_RANK + QK_ROPE_DIM + 3 * CONV_WIDTH + MEM_WIDTH + MIX_WIDTH

kernel_name = "hybrid_mla_shortconv_memory_encoder"


def rmsnorm(x, g):
    x32 = x.astype(jnp.float32)
    y = x32 * lax.rsqrt(jnp.mean(x32 * x32, axis=-1, keepdims=True) + EPS)
    return (y * g.astype(jnp.float32)).astype(x.dtype)


def rope_tables(positions):
    inv_freq = 1.0 / (ROPE_THETA ** (jnp.arange(0, QK_ROPE_DIM, 2, dtype=jnp.float32) / QK_ROPE_DIM))
    ang = positions.astype(jnp.float32)[..., None] * inv_freq
    return jnp.cos(ang), jnp.sin(ang)


def apply_rope(x, cos, sin):
    half = x.shape[-1] // 2
    x32 = x.astype(jnp.float32)
    x1, x2 = x32[..., :half], x32[..., half:]
    return jnp.concatenate([x1 * cos - x2 * sin, x2 * cos + x1 * sin], axis=-1).astype(x.dtype)


def split_cols(z):
    idx = list(np.cumsum(IN_SPLITS)[:-1])
    return jnp.split(z, idx, axis=-1)


def mla_attention(q, k, v):
    b, s, h, dq = q.shape
    nb = s // Q_BLOCK
    scale = QK_HEAD_DIM ** -0.5
    qb = q.reshape(b, nb, Q_BLOCK, h, dq).transpose(1, 0, 2, 3, 4)

    def block(qi):
        sc = jnp.einsum('bqhd,bkhd->bhqk', qi, k).astype(jnp.float32) * scale
        p = jax.nn.softmax(sc, axis=-1).astype(v.dtype)
        return jnp.einsum('bhqk,bkhd->bqhd', p, v)

    o = lax.map(block, qb)
    return o.transpose(1, 0, 2, 3, 4).reshape(b, s, h * V_HEAD_DIM)


def short_gated_conv(gb, gc, xin, w):
    u = gc * xin
    up = jnp.pad(u, ((0, 0), (1, 1), (0, 0)))
    conv = up[:, :-2] * w[0] + up[:, 1:-1] * w[1] + up[:, 2:] * w[2]
    return gb * conv


def memory_attention(q, mem_n, w_mk, w_mv):
    b, m, _ = mem_n.shape
    mk = (mem_n @ w_mk).reshape(b, m, MEM_HEADS, MEM_HEAD_DIM)
    mv = (mem_n @ w_mv).reshape(b, m, MEM_HEADS, MEM_HEAD_DIM)
    sc = jnp.einsum('bshd,bmhd->bhsm', q, mk).astype(jnp.float32) * (MEM_HEAD_DIM ** -0.5)
    p = jax.nn.softmax(sc, axis=-1).astype(mv.dtype)
    o = jnp.einsum('bhsm,bmhd->bshd', p, mv)
    return o.reshape(b, q.shape[1], MEM_WIDTH)


def setup_inputs(seed: int = 0) -> dict:
    key = jax.random.key(seed)
    ks = jax.random.split(key, 16)
    f32 = jnp.float32

    def w(k, shape, fan_in):
        return jax.random.normal(k, shape, f32) * (fan_in ** -0.5)

    def gain(k, shape):
        return 1.0 + 0.02 * jax.random.normal(k, shape, f32)

    x = jax.random.normal(ks[0], (BATCH, SEQ, D_MODEL), f32)
    mem = jax.random.normal(ks[1], (BATCH, MEM_TOKENS, D_MODEL), f32)
    offset = jax.random.randint(ks[2], (BATCH, 1), 0, 4096, dtype=jnp.int32)
    positions = (offset + jnp.arange(SEQ, dtype=jnp.int32)[None, :]).astype(jnp.int32)
    return {
        "x": x,
        "mem": mem,
        "positions": positions,
        "pre_norm_g": gain(ks[3], (DEPTH, D_MODEL)),
        "w_in": w(ks[4], (DEPTH, D_MODEL, IN_COLS), D_MODEL),
        "q_norm_g": gain(ks[5], (DEPTH, Q_LORA_RANK)),
        "w_uq": w(ks[6], (DEPTH, Q_LORA_RANK, MLA_HEADS * QK_HEAD_DIM), Q_LORA_RANK),
        "kv_norm_g": gain(ks[7], (DEPTH, KV_LORA_RANK)),
        "w_ukv": w(ks[8], (DEPTH, KV_LORA_RANK, MLA_HEADS * (QK_NOPE_DIM + V_HEAD_DIM)), KV_LORA_RANK),
        "conv_w": w(ks[9], (DEPTH, CONV_K, CONV_WIDTH), CONV_K),
        "mem_norm_g": gain(ks[10], (DEPTH, D_MODEL)),
        "w_mk": w(ks[11], (DEPTH, D_MODEL, MEM_WIDTH), D_MODEL),
        "w_mv": w(ks[12], (DEPTH, D_MODEL, MEM_WIDTH), D_MODEL),
        "w_o": w(ks[13], (DEPTH, MIX_WIDTH, D_MODEL), MIX_WIDTH),
        "post_norm_g": gain(ks[14], (DEPTH, D_MODEL)),
    }


def reference(x, mem, positions, pre_norm_g, w_in, q_norm_g, w_uq, kv_norm_g, w_ukv, conv_w,
              mem_norm_g, w_mk, w_mv, w_o, post_norm_g):
    b, s, _ = x.shape
    cos, sin = rope_tables(positions)
    for l in range(DEPTH):
        h = rmsnorm(x, pre_norm_g[l])
        z = h @ w_in[l]
        q_lat, kv_lat, k_pe, gb, gc, xin, q_mem, gate = split_cols(z)

        q = (rmsnorm(q_lat, q_norm_g[l]) @ w_uq[l]).reshape(b, s, MLA_HEADS, QK_HEAD_DIM)
        q = jnp.concatenate([q[..., :QK_NOPE_DIM],
                             apply_rope(q[..., QK_NOPE_DIM:], cos[:, :, None, :], sin[:, :, None, :])], axis=-1)
        kv = (rmsnorm(kv_lat, kv_norm_g[l]) @ w_ukv[l]).reshape(b, s, MLA_HEADS, QK_NOPE_DIM + V_HEAD_DIM)
        k_nope, v = kv[..., :QK_NOPE_DIM], kv[..., QK_NOPE_DIM:]
        k_pe = apply_rope(k_pe, cos, sin)
        k = jnp.concatenate([k_nope, jnp.broadcast_to(k_pe[:, :, None, :], (b, s, MLA_HEADS, QK_ROPE_DIM))], axis=-1)
        a_out = mla_attention(q, k, v)

        c_out = short_gated_conv(gb, gc, xin, conv_w[l])

        mem_n = rmsnorm(mem, mem_norm_g[l])
        m_out = memory_attention(q_mem.reshape(b, s, MEM_HEADS, MEM_HEAD_DIM), mem_n, w_mk[l], w_mv[l])

        y = jnp.concatenate([a_out, c_out, m_out], axis=-1) * jax.nn.silu(gate)
        o = y @ w_o[l]
        x = x + rmsnorm(o, post_norm_g[l])
    return x
```

```cpp
#include <hip/hip_runtime.h>
#include <hip/hip_cooperative_groups.h>
#include <cstdio>
#include <cstdint>
#include <cmath>
namespace cg = cooperative_groups;
namespace pg8 {
#define PG8_LAS __attribute__((address_space(3)))
typedef unsigned short bf16_t;
typedef short bf16x8 __attribute__((ext_vector_type(8)));
typedef float f32x4 __attribute__((ext_vector_type(4)));
typedef unsigned u32x4 __attribute__((ext_vector_type(4)));
constexpr int BM = 256, BK = 64, HALF = 128, HTB = HALF * BK * 2  , STAGE_BYTES = 8 * HTB, NXCD = 8, WGM = 8;

__host__ __device__ __forceinline__ int lds_byte(int r, int c) { const int st = (r >> 4) * 2 + (c >> 5), rr = r & 15, cc = c & 31, ob = rr * 64 + cc * 2; return st * 1024 + (ob ^ (((ob >> 9) & 1) << 5)); }
__host__ __device__ __forceinline__ void stage_rc(int b, int& R, int& C) { const int st = b / 1024, sb = b % 1024, swz = sb ^ (((sb >> 9) & 1) << 5); R = (st >> 1) * 16 + swz / 64; C = (st & 1) * 32 + (swz % 64) / 2; }
__host__ __device__ __forceinline__ int perm32(int rho) { const int n = rho >> 4, i = rho & 15; return 8 * (i >> 2) + 4 * n + (i & 3); }

struct Unit { int pm, pn; };
struct Gemm { const bf16_t* A; const bf16_t* Bt; int M, N, K, lda; };

struct StaticOrder {
    int nM, nN, nwg, G, c;
    __host__ __device__ void init(int M, int N, int G_, int c_) { nM = M / BM; nN = N / BM; nwg = nM * nN; G = G_; c = c_; }
    __host__ __device__ bool next(int i, Unit& u) const {
        const long L = (long)i * G + c; if (L >= nwg) return false;
        int wgid = (int)L; { const int q = nwg / NXCD, r = nwg % NXCD, xcd = wgid % NXCD, off = wgid / NXCD; wgid = (xcd < r ? xcd * (q + 1) : r * (q + 1) + (xcd - r) * q) + off; }
        const int nig = WGM * nN, gid = wgid / nig, fm = gid * WGM, gsz = (nM - fm) < WGM ? (nM - fm) : WGM;
        u.pm = fm + ((wgid % nig) % gsz); u.pn = (wgid % nig) / gsz; return true;
    }
    __device__ __forceinline__ void a_ready(const Unit&) const {}
    __device__ __forceinline__ void done(const Unit&) const {}
};
__device__ __forceinline__ unsigned cvt_pk_bf16(float lo, float hi) { unsigned r; asm volatile("v_cvt_pk_bf16_f32 %0, %1, %2" : "=v"(r) : "v"(lo), "v"(hi)); return r; }
typedef float f32x2 __attribute__((ext_vector_type(2)));
__device__ __forceinline__ f32x4 silu4(f32x4 v) {
    f32x4 r;
#pragma unroll
    for (int i = 0; i < 4; ++i) r[i] = v[i] * __builtin_amdgcn_rcpf(1.0f + __builtin_amdgcn_exp2f(-1.4426950408889634f * v[i]));
    return r;
}
__device__ __forceinline__ void st_bf16x8(bf16_t* p, f32x4 v0, f32x4 v1) {
    u32x4 w; w.x = cvt_pk_bf16(v0[0], v0[1]); w.y = cvt_pk_bf16(v0[2], v0[3]); w.z = cvt_pk_bf16(v1[0], v1[1]); w.w = cvt_pk_bf16(v1[2], v1[3]);
    *(u32x4*)p = w;
}
struct EpiZ {
    static constexpr bool PERM = true, AFTER_DRAIN = false;
    bf16_t* Z; float* ssq; const float* ssqx; int ldc, silu_from, ssq_to;
    __device__ __forceinline__ void operator()(const f32x4 (&acc)[2][2][4][2], const Unit& u, int wr, int wc, int fr, int fq) const {
        int frq = fr; asm volatile("" : "+v"(frq));
        const int row0 = u.pm * BM + wr * 64 + frq, col0 = u.pn * BM + wc * 32 + 8 * fq;
        const bool do_silu = u.pn >= silu_from, do_ssq = u.pn < ssq_to;
        float rsv[2][4];
#pragma unroll
        for (int ai = 0; ai < 2; ++ai)
#pragma unroll
            for (int m = 0; m < 4; ++m) rsv[ai][m] = ssqx[row0 + ai * HALF + m * 16];
#pragma unroll
        for (int ai = 0; ai < 2; ++ai)
#pragma unroll
            for (int m = 0; m < 4; ++m) rsv[ai][m] = 1.0f / sqrtf(rsv[ai][m] * (1.0f / 2048.0f) + 1e-6f);
        __builtin_amdgcn_sched_barrier(0);
#pragma unroll
        for (int ai = 0; ai < 2; ++ai)
#pragma unroll
            for (int m = 0; m < 4; ++m) { const int row = row0 + ai * HALF + m * 16; bf16_t* rowp = Z + (size_t)row * ldc + col0; float s = 0.f;
                const float rs = rsv[ai][m];
#pragma unroll
                for (int bj = 0; bj < 2; ++bj) { f32x4 v0 = acc[ai][bj][m][0] * rs, v1 = acc[ai][bj][m][1] * rs;
                    if (do_silu) { v0 = silu4(v0); v1 = silu4(v1); }
                    if (do_ssq) s += (v0[0] * v0[0] + v0[1] * v0[1]) + (v0[2] * v0[2] + v0[3] * v0[3]) + (v1[0] * v1[0] + v1[1] * v1[1]) + (v1[2] * v1[2] + v1[3] * v1[3]);
                    st_bf16x8(rowp + bj * HALF, v0, v1); }
                if (do_ssq) { s += __shfl_xor(s, 16); s += __shfl_xor(s, 32); if (fq == 0) ssq[(size_t)row * 12 + u.pn * 4 + wc] = s; }
                __builtin_amdgcn_sched_barrier(0); }
    }
};
struct EpiRow {
    static constexpr bool PERM = true, AFTER_DRAIN = false;
    bf16_t* O; int ldc; const float* ssq; int s0, ns; float invk;
    __device__ __forceinline__ void operator()(const f32x4 (&acc)[2][2][4][2], const Unit& u, int wr, int wc, int fr, int fq) const {
        int frq = fr; asm volatile("" : "+v"(frq));
        const int row0 = u.pm * BM + wr * 64 + frq, col0 = u.pn * BM + wc * 32 + 8 * fq;
        float scv[2][4];
        if (ns) {
            f32x4 t0[2][4], t1[2][4];
#pragma unroll
            for (int ai = 0; ai < 2; ++ai)
#pragma unroll
                for (int m = 0; m < 4; ++m) { const float* sp = ssq + (size_t)(row0 + ai * HALF + m * 16) * 12 + s0; t0[ai][m] = *(const f32x4*)sp; t1[ai][m] = (ns > 4) ? *(const f32x4*)(sp + 4) : (f32x4){0.f, 0.f, 0.f, 0.f}; }
#pragma unroll
            for (int ai = 0; ai < 2; ++ai)
#pragma unroll
                for (int m = 0; m < 4; ++m) { const f32x4 a = t0[ai][m], b = t1[ai][m]; const float t = ((a[0] + a[1]) + (a[2] + a[3])) + ((b[0] + b[1]) + (b[2] + b[3])); scv[ai][m] = 1.0f / sqrtf(t * invk + 1e-6f); }
        } else {
#pragma unroll
            for (int ai = 0; ai < 2; ++ai)
#pragma unroll
                for (int m = 0; m < 4; ++m) scv[ai][m] = 1.f;
        }
        __builtin_amdgcn_sched_barrier(0);
#pragma unroll
        for (int ai = 0; ai < 2; ++ai)
#pragma unroll
            for (int m = 0; m < 4; ++m) { const int row = row0 + ai * HALF + m * 16; bf16_t* rowp = O + (size_t)row * ldc + col0; const float sc = scv[ai][m];
#pragma unroll
                for (int bj = 0; bj < 2; ++bj) st_bf16x8(rowp + bj * HALF, acc[ai][bj][m][0] * sc, acc[ai][bj][m][1] * sc);
                __builtin_amdgcn_sched_barrier(0); }
    }
};
template <class Epi, class Sched, bool ALIGN_EPI = false, bool SP2 = false>
__device__ __forceinline__ void gemm_phase(PG8_LAS unsigned char* lds, const Gemm g, const Sched& S, const Epi& E) {
    int tid_l = threadIdx.x; asm volatile("" : "+v"(tid_l));
    const int tid = tid_l, wid = __builtin_amdgcn_readfirstlane(tid >> 6), lane = tid & 63, wr = wid >> 2, wc = wid & 3, fr = lane & 15, fq = lane >> 4;
    const int K = g.K, nt = K / BK;
    unsigned voffA[2], voffB[2];
#pragma unroll
    for (int i = 0; i < 2; ++i) { int R, C; stage_rc(tid * 16 + i * 8192, R, C); const int Rb = Epi::PERM ? ((R & ~31) + perm32(R & 31)) : R;
        voffA[i] = (unsigned)(R * g.lda + C) * 2u; voffB[i] = (unsigned)(Rb * K + C) * 2u; }
    const size_t kstep = (size_t)(BK * 2);
    const size_t hstepB = (size_t)HALF * K * 2, hstepA = (size_t)HALF * g.lda * 2;
    const size_t tstepB = 2 * hstepB, tstepA = 2 * hstepA;
    const unsigned ldsw = (unsigned)wid * 1024u;
    const int aoff = lds_byte(wr * 64 + fr, fq * 8), boff = lds_byte(wc * 32 + fr, fq * 8);
#define PG8_SA(b, h) (((b) * 2 + (h)) * HTB)
#define PG8_SB(b, h) ((4 + (b) * 2 + (h)) * HTB)
#define PG8_STAGE(bufoff, gbase, voff) do { _Pragma("unroll") for (int _i = 0; _i < 2; ++_i) \
        __builtin_amdgcn_global_load_lds((const unsigned*)((const char*)(gbase) + (voff)[_i]), (PG8_LAS unsigned*)(lds + (bufoff) + ldsw + _i * 8192), 16, 0, 0); } while (0)
#define PG8_LDA(dst, b, h) do { _Pragma("unroll") for (int m = 0; m < 4; ++m) _Pragma("unroll") for (int k = 0; k < 2; ++k) dst[m][k] = *(const PG8_LAS bf16x8*)(lds + PG8_SA(b, h) + aoff + m * 2048 + k * 1024); } while (0)
#define PG8_LDB(dst, b, h) do { _Pragma("unroll") for (int n = 0; n < 2; ++n) _Pragma("unroll") for (int k = 0; k < 2; ++k) dst[n][k] = *(const PG8_LAS bf16x8*)(lds + PG8_SB(b, h) + boff + n * 2048 + k * 1024); } while (0)
#define PG8_MMA(ai, bj, At, Bt) do { __builtin_amdgcn_s_setprio(1); _Pragma("unroll") for (int m = 0; m < 4; ++m) _Pragma("unroll") for (int n = 0; n < 2; ++n) _Pragma("unroll") for (int k = 0; k < 2; ++k) \
        acc[ai][bj][m][n] = __builtin_amdgcn_mfma_f32_16x16x32_bf16(Bt[n][k], At[m][k], acc[ai][bj][m][n], 0, 0, 0); __builtin_amdgcn_s_setprio(0); } while (0)
#define PG8_WAIT_V(n) asm volatile("s_waitcnt vmcnt(" #n ")" ::: "memory")
#define PG8_WAIT_L(n) asm volatile("s_waitcnt lgkmcnt(" #n ")" ::: "memory")
#define PG8_BAR __builtin_amdgcn_s_barrier()
#define PG8_SCHED __builtin_amdgcn_sched_barrier(0)
    Unit cur, nxt; int ui = 0;
    if (!S.next(0, cur)) return;
    f32x4 acc[2][2][4][2];
#pragma unroll
    for (int a = 0; a < 2; ++a)
#pragma unroll
        for (int b = 0; b < 2; ++b)
#pragma unroll
            for (int m = 0; m < 4; ++m)
#pragma unroll
                for (int n = 0; n < 2; ++n) acc[a][b][m][n] = (f32x4){0.f, 0.f, 0.f, 0.f};
    bf16x8 At[4][2], B0[2][2], B1[2][2];
    const char* cA = (const char*)g.A + (size_t)cur.pm * tstepA; const char* cB = (const char*)g.Bt + (size_t)cur.pn * tstepB;
    S.a_ready(cur);
    if constexpr (SP2) {
        PG8_STAGE(PG8_SB(0, 0), cB, voffB); PG8_STAGE(PG8_SB(0, 1), cB + hstepB, voffB); PG8_STAGE(PG8_SA(0, 0), cA, voffA); PG8_STAGE(PG8_SA(0, 1), cA + hstepA, voffA);
        if (wr == 1) PG8_BAR;
        PG8_WAIT_V(2); PG8_BAR;
        PG8_STAGE(PG8_SB(1, 0), cB + kstep, voffB); PG8_STAGE(PG8_SA(1, 0), cA + kstep, voffA); PG8_STAGE(PG8_SB(1, 1), cB + hstepB + kstep, voffB);
        PG8_WAIT_V(6); PG8_BAR;
    } else {
        PG8_STAGE(PG8_SB(0, 0), cB, voffB); PG8_STAGE(PG8_SA(0, 0), cA, voffA); PG8_STAGE(PG8_SB(0, 1), cB + hstepB, voffB); PG8_STAGE(PG8_SA(0, 1), cA + hstepA, voffA);
        if (wr == 1) PG8_BAR;
        PG8_WAIT_V(4); PG8_BAR;
        PG8_STAGE(PG8_SB(1, 0), cB + kstep, voffB); PG8_STAGE(PG8_SA(1, 0), cA + kstep, voffA); PG8_STAGE(PG8_SB(1, 1), cB + hstepB + kstep, voffB);
        PG8_WAIT_V(6); PG8_BAR;
    }
    for (;;) {
        const bool has_next = S.next(ui + 1, nxt);
        const char* nA = has_next ? (const char*)g.A + (size_t)nxt.pm * tstepA : cA; const char* nB = has_next ? (const char*)g.Bt + (size_t)nxt.pn * tstepB : cB;
        for (int t = 0; t < nt; t += 2) {
            const bool last = (t == nt - 2);
            const char* a1 = cA + (size_t)(t + 1) * kstep;
            const char* a2 = last ? nA : cA + (size_t)(t + 2) * kstep; const char* b2 = last ? nB : cB + (size_t)(t + 2) * kstep;
            const char* a3 = a2 + kstep; const char* b3 = b2 + kstep;
            if (last && has_next) S.a_ready(nxt);
            if constexpr (SP2) {
            PG8_LDB(B0, 0, 0); PG8_LDB(B1, 0, 1); PG8_SCHED; PG8_LDA(At, 0, 0); PG8_STAGE(PG8_SA(1, 1), a1 + hstepA, voffA);
            PG8_WAIT_V(8); PG8_WAIT_L(0); PG8_BAR; PG8_MMA(0, 0, At, B0); PG8_MMA(0, 1, At, B1); PG8_BAR; PG8_SCHED;
            PG8_LDA(At, 0, 1); PG8_STAGE(PG8_SB(0, 0), b2, voffB); PG8_STAGE(PG8_SB(0, 1), b2 + hstepB, voffB); PG8_STAGE(PG8_SA(0, 0), a2, voffA);
            PG8_WAIT_V(8); PG8_WAIT_L(0); PG8_BAR; PG8_MMA(1, 0, At, B0); PG8_MMA(1, 1, At, B1); PG8_BAR; PG8_SCHED;
            PG8_LDB(B0, 1, 0); PG8_LDB(B1, 1, 1); PG8_SCHED; PG8_LDA(At, 1, 0); PG8_STAGE(PG8_SA(0, 1), a2 + hstepA, voffA);
            PG8_WAIT_V(8); PG8_WAIT_L(0); PG8_BAR; PG8_MMA(0, 0, At, B0); PG8_MMA(0, 1, At, B1); PG8_BAR; PG8_SCHED;
            PG8_LDA(At, 1, 1); PG8_STAGE(PG8_SB(1, 0), b3, voffB); PG8_STAGE(PG8_SB(1, 1), b3 + hstepB, voffB); PG8_STAGE(PG8_SA(1, 0), a3, voffA);
            PG8_WAIT_V(8); PG8_WAIT_L(0); PG8_BAR; PG8_MMA(1, 0, At, B0); PG8_MMA(1, 1, At, B1); PG8_BAR; PG8_SCHED;
            } else {
            PG8_LDB(B0, 0, 0); PG8_SCHED; PG8_LDA(At, 0, 0); PG8_STAGE(PG8_SA(1, 1), a1 + hstepA, voffA);
            PG8_WAIT_L(8); PG8_BAR; PG8_WAIT_L(0); PG8_MMA(0, 0, At, B0); PG8_BAR; PG8_SCHED;
            PG8_LDB(B1, 0, 1); PG8_STAGE(PG8_SB(0, 0), b2, voffB);
            PG8_BAR; PG8_WAIT_L(0); PG8_MMA(0, 1, At, B1); PG8_BAR;
            PG8_LDA(At, 0, 1); PG8_STAGE(PG8_SA(0, 0), a2, voffA);
            PG8_BAR; PG8_WAIT_L(0); PG8_MMA(1, 0, At, B0); PG8_BAR; PG8_SCHED;
            PG8_STAGE(PG8_SB(0, 1), b2 + hstepB, voffB);
            PG8_WAIT_V(6); PG8_BAR; PG8_MMA(1, 1, At, B1); PG8_BAR;
            PG8_LDB(B0, 1, 0); PG8_SCHED; PG8_LDA(At, 1, 0); PG8_STAGE(PG8_SA(0, 1), a2 + hstepA, voffA);
            PG8_WAIT_L(8); PG8_BAR; PG8_WAIT_L(0); PG8_MMA(0, 0, At, B0); PG8_BAR; PG8_SCHED;
            PG8_LDB(B1, 1, 1); PG8_STAGE(PG8_SB(1, 0), b3, voffB);
            PG8_BAR; PG8_WAIT_L(0); PG8_MMA(0, 1, At, B1); PG8_BAR;
            PG8_LDA(At, 1, 1); PG8_STAGE(PG8_SA(1, 0), a3, voffA);
            PG8_BAR; PG8_WAIT_L(0); PG8_MMA(1, 0, At, B0); PG8_BAR; PG8_SCHED;
            PG8_STAGE(PG8_SB(1, 1), b3 + hstepB, voffB);
            PG8_WAIT_V(6); PG8_BAR; PG8_MMA(1, 1, At, B1); PG8_BAR;
            }
        }
        if constexpr (ALIGN_EPI) { if (wr == 0) PG8_BAR; }
        if constexpr (!Epi::AFTER_DRAIN) { E(acc, cur, wr, wc, fr, fq); S.done(cur); }
        if (!has_next) break;
#pragma unroll
        for (int a = 0; a < 2; ++a)
#pragma unroll
            for (int b = 0; b < 2; ++b)
#pragma unroll
                for (int m = 0; m < 4; ++m)
#pragma unroll
                    for (int n = 0; n < 2; ++n) acc[a][b][m][n] = (f32x4){0.f, 0.f, 0.f, 0.f};
        cur = nxt; cA = nA; cB = nB; ++ui;
        if constexpr (ALIGN_EPI) { if (wr == 1) PG8_BAR; }
    }
    PG8_WAIT_V(0);
    if constexpr (!ALIGN_EPI) { if (wr == 0) PG8_BAR; }
    PG8_BAR;
    if constexpr (Epi::AFTER_DRAIN) { E.fused(acc, cur, wr, wc, fr, fq, lds, wid, lane); S.done(cur); }
#undef PG8_SA
#undef PG8_SB
#undef PG8_STAGE
#undef PG8_LDA
#undef PG8_LDB
#undef PG8_MMA
#undef PG8_WAIT_V
#undef PG8_WAIT_L
#undef PG8_BAR
#undef PG8_SCHED
}
}
namespace att {
typedef unsigned short bf16;
using bf16x8 = __attribute__((ext_vector_type(8))) short;
using s16x4  = __attribute__((ext_vector_type(4))) short;
using f32x16 = __attribute__((ext_vector_type(16))) float;
using f32x4  = __attribute__((ext_vector_type(4))) float;
using u32x4  = __attribute__((ext_vector_type(4))) unsigned;
constexpr int NW = 8, QBLK = 32, KVBLK = 64;
constexpr int SHM_V = 16384, SHM_K = 16384, SHM_KR = 8192;
constexpr int NVBUF = 3;
constexpr int OFF_V = 0, OFF_K = NVBUF * SHM_V, OFF_KR = OFF_K + 2 * SHM_K, OFF_WS = OFF_KR + 2 * SHM_KR, OFF_QR = OFF_WS + NW * 64 * 4, LDS_BYTES = OFF_QR + NW * 4096;
constexpr float THR = 8.f;
#define KSWZ(row, colB) ((row) * 256 + ((colB) ^ (((row) & 15) << 4)))
#define KRSWZ(row, colB) ((row) * 128 + ((colB) ^ ((((row) >> 1) & 7) << 4)))
#define SBAR() __builtin_amdgcn_sched_barrier(0)
__device__ __forceinline__ int crow(int r, int hi) { return (r & 3) + 8 * (r >> 2) + 4 * hi; }
__device__ __forceinline__ unsigned cvtpk(float lo, float hi) { unsigned r; asm volatile("v_cvt_pk_bf16_f32 %0, %1, %2" : "=v"(r) : "v"(lo), "v"(hi)); return r; }
__device__ __forceinline__ float bf2f(short s) { return __uint_as_float(((unsigned)(unsigned short)s) << 16); }
template <bool MLA> struct Sc { static constexpr float SCALE = MLA ? 0.07216878364870322f : 0.08838834764831845f; };

template <bool MLA> __device__ __forceinline__ void partialSM(f32x16& p0, f32x16& p1, float& m_reg, float& mn, float& alpha) {
  constexpr float SCALE = Sc<MLA>::SCALE; constexpr float C = SCALE * 1.4426950408889634f;
  float pmax = p0[0]; for (int r = 1; r < 16; ++r) pmax = fmaxf(pmax, p0[r]); for (int r = 0; r < 16; ++r) pmax = fmaxf(pmax, p1[r]);
  { auto rr = __builtin_amdgcn_permlane32_swap(__float_as_uint(pmax), __float_as_uint(pmax), false, false);
    pmax = fmaxf(__uint_as_float(rr[0]), __uint_as_float(rr[1])); }
  if (__builtin_expect(__all(pmax - m_reg <= THR / SCALE), 1)) { mn = m_reg; alpha = 1.f; }
  else { mn = fmaxf(m_reg, pmax); alpha = __builtin_amdgcn_exp2f((m_reg - mn) * C); m_reg = mn; }
  float mnC = -mn * C;
  for (int r = 0; r < 16; ++r) p0[r] = fmaf(p0[r], C, mnC); for (int r = 0; r < 16; ++r) p1[r] = fmaf(p1[r], C, mnC);
  for (int r = 0; r < 16; ++r) p0[r] = __builtin_amdgcn_exp2f(p0[r]);
}
__device__ __forceinline__ void finishSM(f32x16& p0, f32x16& p1, float alpha, float& l_reg, bf16x8& pa0, bf16x8& pa1, bf16x8& pa2, bf16x8& pa3) {
  for (int r = 0; r < 16; ++r) p1[r] = __builtin_amdgcn_exp2f(p1[r]);
  float ps = 0; for (int r = 0; r < 16; ++r) ps += p0[r]; for (int r = 0; r < 16; ++r) ps += p1[r];
  { auto rr = __builtin_amdgcn_permlane32_swap(__float_as_uint(ps), __float_as_uint(ps), false, false);
    ps = __uint_as_float(rr[0]) + __uint_as_float(rr[1]); }
  l_reg = l_reg * alpha + ps;
#define PK4(P, BASE, OUT) do { unsigned a0 = cvtpk(P[BASE + 0], P[BASE + 1]), a1 = cvtpk(P[BASE + 2], P[BASE + 3]);   \
    unsigned b0 = cvtpk(P[BASE + 4], P[BASE + 5]), b1 = cvtpk(P[BASE + 6], P[BASE + 7]);                              \
    auto r0 = __builtin_amdgcn_permlane32_swap(a0, b0, false, false); auto r1 = __builtin_amdgcn_permlane32_swap(a1, b1, false, false); \
    u32x4 w = {r0[0], r1[0], r0[1], r1[1]}; OUT = *reinterpret_cast<bf16x8*>(&w); } while (0)
  PK4(p0, 0, pa0); PK4(p0, 8, pa1); PK4(p1, 0, pa2); PK4(p1, 8, pa3);
#undef PK4
}
template <bool MLA> __device__ __forceinline__ void qkt(f32x16& p0, f32x16& p1, const char* Ks, const char* Krs, const bf16x8* qr, const char* qrl, int r32, int hi) {
  p0 = f32x16{}; p1 = f32x16{};
#pragma unroll
  for (int d0 = 0; d0 < 8; ++d0) { int cb = (d0 * 16 + hi * 8) * 2;
    bf16x8 b0 = *reinterpret_cast<const bf16x8*>(Ks + KSWZ(r32, cb));
    bf16x8 b1 = *reinterpret_cast<const bf16x8*>(Ks + KSWZ(32 + r32, cb));
    p0 = __builtin_amdgcn_mfma_f32_32x32x16_bf16(b0, qr[d0], p0, 0, 0, 0);
    p1 = __builtin_amdgcn_mfma_f32_32x32x16_bf16(b1, qr[d0], p1, 0, 0, 0); }
  if constexpr (MLA) {
#pragma unroll
    for (int d0 = 0; d0 < 4; ++d0) { int cb = (d0 * 16 + hi * 8) * 2;
      bf16x8 b0 = *reinterpret_cast<const bf16x8*>(Krs + KRSWZ(r32, cb));
      bf16x8 b1 = *reinterpret_cast<const bf16x8*>(Krs + KRSWZ(32 + r32, cb));
      const bf16x8 qf = *reinterpret_cast<const bf16x8*>(qrl + d0 * 1024);
      p0 = __builtin_amdgcn_mfma_f32_32x32x16_bf16(b0, qf, p0, 0, 0, 0);
      p1 = __builtin_amdgcn_mfma_f32_32x32x16_bf16(b1, qf, p1, 0, 0, 0); }
  }
}
__device__ __forceinline__ int v_st(int k, int c) { const int kk = (k & ~0xC) | ((k & 4) << 1) | ((k & 8) >> 1); return ((kk >> 3) * 4 + (c >> 5)) * 512 + ((kk & 7) * 32 + (c & 31)) * 2; }
__device__ __forceinline__ int v_rd_base(int lane) { return ((lane & 3) << 3) | (((lane >> 2) & 3) << 6) | (((lane >> 4) & 1) << 5) | (((lane >> 5) & 1) << 8); }
constexpr int v_rd_off(int d0, int ks, int half) { return d0 * 512 + ks * 4096 + half * 2048; }
template <int OFF> __device__ __forceinline__ s16x4 tr_read(int vb) {
  s16x4 r; asm volatile("ds_read_b64_tr_b16 %0, %1 offset:%2" : "=&v"(r) : "v"(vb), "i"(OFF) : "memory"); return r;
}
template <int D0> __device__ __forceinline__ void pv_one(f32x16& od, int vb, bf16x8 pa0, bf16x8 pa1, bf16x8 pa2, bf16x8 pa3) {
  s16x4 l0 = tr_read<v_rd_off(D0, 0, 0)>(vb), h0 = tr_read<v_rd_off(D0, 0, 1)>(vb), l1 = tr_read<v_rd_off(D0, 1, 0)>(vb), h1 = tr_read<v_rd_off(D0, 1, 1)>(vb);
  s16x4 l2 = tr_read<v_rd_off(D0, 2, 0)>(vb), h2 = tr_read<v_rd_off(D0, 2, 1)>(vb), l3 = tr_read<v_rd_off(D0, 3, 0)>(vb), h3 = tr_read<v_rd_off(D0, 3, 1)>(vb);
#define PK(L, H) (bf16x8){L[0], L[1], L[2], L[3], H[0], H[1], H[2], H[3]}
  asm volatile("s_waitcnt lgkmcnt(6)" : "+v"(l0), "+v"(h0) :: "memory"); SBAR();
  od = __builtin_amdgcn_mfma_f32_32x32x16_bf16(pa0, PK(l0, h0), od, 0, 0, 0);
  asm volatile("s_waitcnt lgkmcnt(4)" : "+v"(l1), "+v"(h1) :: "memory"); SBAR();
  od = __builtin_amdgcn_mfma_f32_32x32x16_bf16(pa1, PK(l1, h1), od, 0, 0, 0);
  asm volatile("s_waitcnt lgkmcnt(2)" : "+v"(l2), "+v"(h2) :: "memory"); SBAR();
  od = __builtin_amdgcn_mfma_f32_32x32x16_bf16(pa2, PK(l2, h2), od, 0, 0, 0);
  asm volatile("s_waitcnt lgkmcnt(0)" : "+v"(l3), "+v"(h3) :: "memory"); SBAR();
  od = __builtin_amdgcn_mfma_f32_32x32x16_bf16(pa3, PK(l3, h3), od, 0, 0, 0);
#undef PK
}
__device__ __forceinline__ void pv_d0(f32x16* o, int vb, bf16x8 pa0, bf16x8 pa1, bf16x8 pa2, bf16x8 pa3) {
  pv_one<0>(o[0], vb, pa0, pa1, pa2, pa3); pv_one<1>(o[1], vb, pa0, pa1, pa2, pa3); pv_one<2>(o[2], vb, pa0, pa1, pa2, pa3); pv_one<3>(o[3], vb, pa0, pa1, pa2, pa3);
}

template <bool MLA, int LDQ, int LDK, int LDSG, int LDY>
__device__ __forceinline__ void attn_body(const bf16* __restrict__ Qb, const bf16* __restrict__ Kh, const bf16* __restrict__ Vh, const bf16* __restrict__ Krh,
                                          const float* __restrict__ cosb, const float* __restrict__ sinb, const bf16* __restrict__ SGb, bf16* __restrict__ Yb, int seq, char* lds) {
  int tid_l = threadIdx.x; asm volatile("" : "+v"(tid_l));
  const int tid = tid_l, wid = __builtin_amdgcn_readfirstlane(tid >> 6), lane = tid & 63, r32 = lane & 31, hi = lane >> 5;
  char* V_lds = lds + OFF_V; char* K_lds = lds + OFF_K; char* KR_lds = lds + OFF_KR;
  float* ws = (float*)(lds + OFF_WS) + wid * 64; float* li_l = ws; float* al_l = ws + 32;
  float m_reg = -1e30f, l_reg = 0; f32x16 o[4] = {}; bf16x8 qr[8]; char* qrl = lds + OFF_QR + wid * 4096 + lane * 16;
  const bf16* Qw = Qb + (long)(wid * QBLK + r32) * LDQ + hi * 8;
#pragma unroll
  for (int d0 = 0; d0 < 8; ++d0) qr[d0] = *reinterpret_cast<const bf16x8*>(Qw + d0 * 16);
  if constexpr (MLA) {
    const float* cw = cosb + (wid * QBLK + r32) * 32 + hi * 8; const float* sw = sinb + (wid * QBLK + r32) * 32 + hi * 8;
#pragma unroll
    for (int dp = 0; dp < 2; ++dp) {
      const bf16x8 a = *reinterpret_cast<const bf16x8*>(Qw + 128 + dp * 16), b = *reinterpret_cast<const bf16x8*>(Qw + 160 + dp * 16);
      const f32x4 c0 = *reinterpret_cast<const f32x4*>(cw + dp * 16), c1 = *reinterpret_cast<const f32x4*>(cw + dp * 16 + 4);
      const f32x4 s0 = *reinterpret_cast<const f32x4*>(sw + dp * 16), s1 = *reinterpret_cast<const f32x4*>(sw + dp * 16 + 4);
      float o1[8], o2[8];
#pragma unroll
      for (int e = 0; e < 8; ++e) { const float x1 = bf2f(a[e]), x2 = bf2f(b[e]); const float c = e < 4 ? c0[e & 3] : c1[e & 3], s = e < 4 ? s0[e & 3] : s1[e & 3];
        o1[e] = x1 * c - x2 * s; o2[e] = x2 * c + x1 * s; }
      u32x4 w1 = {cvtpk(o1[0], o1[1]), cvtpk(o1[2], o1[3]), cvtpk(o1[4], o1[5]), cvtpk(o1[6], o1[7])};
      u32x4 w2 = {cvtpk(o2[0], o2[1]), cvtpk(o2[2], o2[3]), cvtpk(o2[4], o2[5]), cvtpk(o2[6], o2[7])};
      *reinterpret_cast<u32x4*>(qrl + dp * 1024) = w1; *reinterpret_cast<u32x4*>(qrl + (2 + dp) * 1024) = w2;
    }
  }
  const int vb0 = (int)(uintptr_t)V_lds + v_rd_base(lane);
  typedef __attribute__((address_space(3))) unsigned lds_u32;
  const unsigned lds0 = (unsigned)(uintptr_t)lds;
  const bf16* srcK[2]; const bf16* srcV[2]; const bf16* srcR = nullptr;
#pragma unroll
  for (int q = 0; q < 2; ++q) { const int pc = 2 * wid + q;
    { const int row = 4 * pc + (lane >> 4), lc = (lane & 15) ^ (row & 15); srcK[q] = Kh + (long)row * LDK + lc * 8; }
    { const int s = 2 * pc + (lane >> 5), kk = ((s >> 2) << 3) | ((lane & 31) >> 2), k = (kk & ~0xC) | ((kk & 4) << 1) | ((kk & 8) >> 1), c = (s & 3) * 32 + (lane & 3) * 8; srcV[q] = Vh + (long)k * LDK + c; } }
  if constexpr (MLA) { const int row = 8 * wid + (lane >> 3), lc = (lane & 7) ^ ((row >> 1) & 7); srcR = Krh + (long)row * 64 + lc * 8; }
#define GLDS(src, off) __builtin_amdgcn_global_load_lds((const unsigned*)(src), (lds_u32*)(uintptr_t)(unsigned)__builtin_amdgcn_readfirstlane((int)(lds0 + (off))), 16, 0, 0)
#define DMA(t, kb, vbuf) do { const long ko_ = (long)(t) * KVBLK * LDK; \
    GLDS(srcK[0] + ko_, OFF_K + (kb) * SHM_K + (2 * wid) * 1024); GLDS(srcK[1] + ko_, OFF_K + (kb) * SHM_K + (2 * wid + 1) * 1024); \
    GLDS(srcV[0] + ko_, OFF_V + (vbuf) * SHM_V + (2 * wid) * 1024); GLDS(srcV[1] + ko_, OFF_V + (vbuf) * SHM_V + (2 * wid + 1) * 1024); \
    if constexpr (MLA) GLDS(srcR + (long)(t) * KVBLK * 64, OFF_KR + (kb) * SHM_KR + wid * 1024); } while (0)
#define RESC(a) do { if (__any((a) < 1.f)) { if (hi == 0) al_l[r32] = (a); asm volatile("s_waitcnt lgkmcnt(0)" ::: "memory"); \
    for (int d = 0; d < 4; ++d) for (int r = 0; r < 16; ++r) o[d][r] *= al_l[crow(r, hi)]; } } while (0)
  f32x16 pA0, pA1, pB0, pB1; float mnA, mnB, alA, alB; bf16x8 pa0, pa1, pa2, pa3; const int NT = seq / KVBLK;
#define WBAR() asm volatile("s_waitcnt vmcnt(0) lgkmcnt(0)\n\ts_barrier" ::: "memory")
  DMA(0, 0, 0); DMA(1, 1, 1); WBAR();
  qkt<MLA>(pA0, pA1, K_lds, KR_lds, qr, qrl, r32, hi); partialSM<MLA>(pA0, pA1, m_reg, mnA, alA);
  WBAR();
  int vprev = 0, vnext = 2;
#define STEP(C0, C1, mnC, alC, Q0, Q1, alQ, j, KB) do { \
    if ((j) + 1 < NT) DMA((j) + 1, (KB) ^ 1, vnext); \
    SBAR(); qkt<MLA>(C0, C1, K_lds + (KB) * SHM_K, KR_lds + (KB) * SHM_KR, qr, qrl, r32, hi); \
    finishSM(Q0, Q1, alQ, l_reg, pa0, pa1, pa2, pa3); SBAR(); \
    pv_d0(o, vb0 + vprev * (int)SHM_V, pa0, pa1, pa2, pa3); partialSM<MLA>(C0, C1, m_reg, mnC, alC); \
    RESC(alC); \
    WBAR(); \
    vprev = (vprev == NVBUF - 1) ? 0 : vprev + 1; vnext = (vnext == NVBUF - 1) ? 0 : vnext + 1; } while (0)
  for (int j = 1; j + 1 < NT; j += 2) { STEP(pB0, pB1, mnB, alB, pA0, pA1, alA, j, 1); STEP(pA0, pA1, mnA, alA, pB0, pB1, alB, j + 1, 0); }
  STEP(pB0, pB1, mnB, alB, pA0, pA1, alA, NT - 1, 1);
#undef STEP
  finishSM(pB0, pB1, alB, l_reg, pa0, pa1, pa2, pa3); SBAR();
  pv_d0(o, vb0 + vprev * (int)SHM_V, pa0, pa1, pa2, pa3);
  WBAR();
#undef WBAR
#undef DMA
#undef GLDS
  if (hi == 0) li_l[r32] = l_reg; asm volatile("s_waitcnt lgkmcnt(0)" ::: "memory");
  float rli[16];
#pragma unroll
  for (int r = 0; r < 16; ++r) rli[r] = __builtin_amdgcn_rcpf(li_l[crow(r, hi)]);
  int lo_ = lane; asm volatile("" : "+v"(lo_));
  char* stg = lds + (wid < 2 ? wid * 8192 : OFF_K + (wid - 2) * 8192);
  { const int r32o = lo_ & 31, hio = lo_ >> 5;
#pragma unroll
    for (int r = 0; r < 16; ++r) { const int orow = (r & 3) + 8 * (r >> 2) + 4 * hio;
#pragma unroll
      for (int d0 = 0; d0 < 4; d0 += 2) { const unsigned w = cvtpk(o[d0][r] * rli[r], o[d0 + 1][r] * rli[r]);
        *(bf16*)(stg + orow * 256 + (d0 * 32 + r32o) * 2) = (bf16)(w & 0xffffu); *(bf16*)(stg + orow * 256 + ((d0 + 1) * 32 + r32o) * 2) = (bf16)(w >> 16); } } }
  asm volatile("s_waitcnt lgkmcnt(0)" ::: "memory");
  { const int rw = lo_ >> 4, ch = lo_ & 15;
    const bf16* SGw = SGb + (long)(wid * QBLK + rw) * LDSG + ch * 8; bf16* Yw = Yb + (long)(wid * QBLK + rw) * LDY + ch * 8;
#pragma unroll
    for (int i = 0; i < 8; ++i) { const u32x4 v = *(const u32x4*)(stg + (i * 4 + rw) * 256 + ch * 16); const u32x4 g = *(const u32x4*)(SGw + (long)(i * 4) * LDSG);
      u32x4 w;
#define MULPK(a, b) cvtpk(__uint_as_float((a) << 16) * __uint_as_float((b) << 16), __uint_as_float((a) & 0xffff0000u) * __uint_as_float((b) & 0xffff0000u))
      w.x = MULPK(v.x, g.x); w.y = MULPK(v.y, g.y); w.z = MULPK(v.z, g.z); w.w = MULPK(v.w, g.w);
#undef MULPK
      *(u32x4*)(Yw + (long)(i * 4) * LDY) = w; } }
  __syncthreads();
#undef RESC
}
#undef SBAR
}
#define LAS __attribute__((address_space(3)))
typedef unsigned short bf16;
typedef float f32x4 __attribute__((ext_vector_type(4)));
typedef unsigned u32x4 __attribute__((ext_vector_type(4)));
typedef unsigned u32x2 __attribute__((ext_vector_type(2)));
constexpr int BATCH = 8, SEQ = 4096, DM = 2048, DEPTH = 4, T = BATCH * SEQ, MEMT = 256, MROWS = BATCH * MEMT;
constexpr int INC = 4928, ZC = 5120;
constexpr int ZO_QLAT = 0, ZO_KVLAT = 512, ZO_KPE = 768, ZO_GB = 1024, ZO_GC = 1536, ZO_XIN = 2048, ZO_QMEM = 2560, ZO_GATE = 3072;
constexpr int QC = 1536, KVC = 2048, MKVC = 4096;
constexpr float EPS = 1e-6f;
constexpr size_t MiB = 1u << 20;
constexpr size_t WS_WIN = 2 * MiB, WS_WUQ = 82 * MiB, WS_WUKV = 88 * MiB, WS_WM = 92 * MiB, WS_WO = 108 * MiB, WS_MEMH = 140 * MiB, WS_MKV = 148 * MiB,
                 WS_COS = 164 * MiB, WS_SIN = 168 * MiB, WS_SSQ = 172 * MiB, WS_KPE = 174 * MiB, WS_HQ = 180 * MiB, WS_KV = 308 * MiB, WS_Y = 436 * MiB, WS_ZO = 564 * MiB, WS_Q = 884 * MiB, WS_END = 980 * MiB;
constexpr size_t WS_SSQX = WS_SSQ + (size_t)T * 12 * 4;
constexpr int LDS_MAIN = 8 * 64 * 65 * 4;
constexpr int LDS_BYTES = LDS_MAIN + 256;
constexpr size_t CTL_BYTES = 16384;
#ifndef MK_DUP
#define MK_DUP -1
#endif
constexpr int NPRO = (MK_DUP == 5) ? 2 : 1, SLOTS = 5 + ((MK_DUP >= 0 && MK_DUP != 5) ? 1 : 0);
constexpr int NPHASE = NPRO + SLOTS * DEPTH;

#ifndef MK_DUP
#define MK_DUP -1
#endif
#ifndef MK_EN
#define MK_EN 0xff
#endif
#define EN(k) ((MK_EN >> (k)) & 1)
struct Params {
    const float *x, *mem; const int* pos; const float *pre_g, *w_in, *qn_g, *w_uq, *kvn_g, *w_ukv, *conv_w, *memn_g, *w_mk, *w_mv, *w_o, *post_g;
    float* out; unsigned char* ws; float inv_freq[32]; int ph_lo, ph_hi;
};

__device__ __forceinline__ unsigned f2bf(float f) { unsigned u = __builtin_bit_cast(unsigned, f); return (u + 0x7fffu + ((u >> 16) & 1u)) >> 16; }
__device__ __forceinline__ unsigned pk2(float lo, float hi) { return f2bf(lo) | (f2bf(hi) << 16); }
__device__ __forceinline__ float bfl(unsigned w) { return __uint_as_float(w << 16); }
__device__ __forceinline__ float bfh(unsigned w) { return __uint_as_float(w & 0xffff0000u); }
__device__ __forceinline__ float wave_sum(float v) {
#pragma unroll
    for (int o = 1; o < 64; o <<= 1) v += __shfl_xor(v, o);
    return v;
}
constexpr int TR_LDS = 64 * 65 * 4;
__device__ __forceinline__ void transpose_item(const float* W, const float* g, int K, int N, bf16* WT, int row_off, int pad_from, int pad_add, LAS float* scr, int item, int lane) {
    const int nblk = N / 64, kb = item / nblk, nb = item % nblk, k0 = 64 * kb, n0 = 64 * nb;
    const int lr = lane >> 4, lc = (lane & 15) * 4;
    f32x4 v[16];
#pragma unroll
    for (int i = 0; i < 16; ++i) v[i] = __builtin_nontemporal_load((const f32x4*)(W + (size_t)(k0 + 4 * i + lr) * N + n0 + lc));
#pragma unroll
    for (int i = 0; i < 16; ++i) { const int kk = 4 * i + lr; f32x4 x = v[i]; if (g) x = x * g[k0 + kk];
        LAS float* d = scr + kk * 65 + lc; d[0] = x.x; d[1] = x.y; d[2] = x.z; d[3] = x.w; }
    asm volatile("s_waitcnt lgkmcnt(0)" ::: "memory");
    const int c = lane & 7; const int drow0 = row_off + n0 + (n0 >= pad_from ? pad_add : 0);
#pragma unroll
    for (int j = 0; j < 8; ++j) { const int n = (lane >> 3) + 8 * j; const LAS float* s = scr + (8 * c) * 65 + n;
        u32x4 o; o.x = pk2(s[0 * 65], s[1 * 65]); o.y = pk2(s[2 * 65], s[3 * 65]); o.z = pk2(s[4 * 65], s[5 * 65]); o.w = pk2(s[6 * 65], s[7 * 65]);
        *(u32x4*)(WT + (size_t)(drow0 + n) * K + k0 + 8 * c) = o; }
    asm volatile("s_waitcnt lgkmcnt(0)" ::: "memory");
}
__device__ __forceinline__ void prenorm_row(const float* xr, const float* g, bf16* hr, int lane) {
    f32x4 v[8]; float s = 0.f;
#pragma unroll
    for (int j = 0; j < 4; ++j) { v[2 * j] = *(const f32x4*)(xr + j * 512 + lane * 8); v[2 * j + 1] = *(const f32x4*)(xr + j * 512 + lane * 8 + 4); }
#pragma unroll
    for (int j = 0; j < 8; ++j) s += (v[j].x * v[j].x + v[j].y * v[j].y) + (v[j].z * v[j].z + v[j].w * v[j].w);
    const float rstd = 1.0f / sqrtf(wave_sum(s) * (1.0f / DM) + EPS);
#pragma unroll
    for (int j = 0; j < 4; ++j) { f32x4 a = v[2 * j] * rstd, b = v[2 * j + 1] * rstd;
        if (g) { a = a * *(const f32x4*)(g + j * 512 + lane * 8); b = b * *(const f32x4*)(g + j * 512 + lane * 8 + 4); }
        u32x4 w; w.x = pk2(a.x, a.y); w.y = pk2(a.z, a.w); w.z = pk2(b.x, b.y); w.w = pk2(b.z, b.w);
        *(u32x4*)(hr + j * 512 + lane * 8) = w; }
}
__device__ __forceinline__ void cvt_row(const float* xr, bf16* hr, float* ssq, int lane) {
    f32x4 v[8]; float s = 0.f;
#pragma unroll
    for (int j = 0; j < 4; ++j) { v[2 * j] = __builtin_nontemporal_load((const f32x4*)(xr + j * 512 + lane * 8)); v[2 * j + 1] = __builtin_nontemporal_load((const f32x4*)(xr + j * 512 + lane * 8 + 4)); }
#pragma unroll
    for (int j = 0; j < 8; ++j) s += (v[j].x * v[j].x + v[j].y * v[j].y) + (v[j].z * v[j].z + v[j].w * v[j].w);
    s = wave_sum(s);
#pragma unroll
    for (int j = 0; j < 4; ++j) { const f32x4 a = v[2 * j], b = v[2 * j + 1];
        u32x4 w; w.x = pk2(a.x, a.y); w.y = pk2(a.z, a.w); w.z = pk2(b.x, b.y); w.w = pk2(b.z, b.w);
        *(u32x4*)(hr + j * 512 + lane * 8) = w; }
    if (lane == 0) *ssq = s;
}
struct RowIn { u32x4 x[4]; u32x4 w[4]; };
__device__ __forceinline__ void post_load(RowIn& R, const bf16* xr, const bf16* orow, int lane) {
#pragma unroll
    for (int j = 0; j < 4; ++j) { R.x[j] = *(const u32x4*)(xr + j * 512 + lane * 8); R.w[j] = __builtin_nontemporal_load((const u32x4*)(orow + j * 512 + lane * 8)); }
}
__device__ __forceinline__ void post_finish(RowIn& R, const float* gpost, bool last, float* outr, bf16* xw, float* ssq, int lane) {
    f32x4 ov[8], v[8]; float s = 0.f;
#pragma unroll
    for (int j = 0; j < 4; ++j) { const u32x4 w = R.w[j], x = R.x[j];
        ov[2 * j] = (f32x4){bfl(w.x), bfh(w.x), bfl(w.y), bfh(w.y)}; ov[2 * j + 1] = (f32x4){bfl(w.z), bfh(w.z), bfl(w.w), bfh(w.w)};
        v[2 * j] = (f32x4){bfl(x.x), bfh(x.x), bfl(x.y), bfh(x.y)}; v[2 * j + 1] = (f32x4){bfl(x.z), bfh(x.z), bfl(x.w), bfh(x.w)}; }
#pragma unroll
    for (int j = 0; j < 8; ++j) s += (ov[j].x * ov[j].x + ov[j].y * ov[j].y) + (ov[j].z * ov[j].z + ov[j].w * ov[j].w);
    const float rso = 1.0f / sqrtf(wave_sum(s) * (1.0f / DM) + EPS);
#pragma unroll
    for (int j = 0; j < 4; ++j) {
        v[2 * j] = v[2 * j] + ov[2 * j] * rso * *(const f32x4*)(gpost + j * 512 + lane * 8);
        v[2 * j + 1] = v[2 * j + 1] + ov[2 * j + 1] * rso * *(const f32x4*)(gpost + j * 512 + lane * 8 + 4); }
    if (last) {
#pragma unroll
        for (int j = 0; j < 4; ++j) { __builtin_nontemporal_store(v[2 * j], (f32x4*)(outr + j * 512 + lane * 8)); __builtin_nontemporal_store(v[2 * j + 1], (f32x4*)(outr + j * 512 + lane * 8 + 4)); }
    } else {
        float s2 = 0.f;
#pragma unroll
        for (int j = 0; j < 8; ++j) s2 += (v[j].x * v[j].x + v[j].y * v[j].y) + (v[j].z * v[j].z + v[j].w * v[j].w);
        s2 = wave_sum(s2);
#pragma unroll
        for (int j = 0; j < 4; ++j) { const f32x4 a = v[2 * j], b = v[2 * j + 1];
            u32x4 w; w.x = pk2(a.x, a.y); w.y = pk2(a.z, a.w); w.z = pk2(b.x, b.y); w.w = pk2(b.z, b.w);
            *(u32x4*)(xw + j * 512 + lane * 8) = w; }
        if (lane == 0) *ssq = s2;
    }
}
__device__ __forceinline__ void sincos_acc(float a, float& s, float& c) {
    const double x = (double)a; const double k = __builtin_rint(x * 0.63661977236758134308);
    const float r = (float)__builtin_fma(-k, 1.57079632679489661923, x), r2 = r * r;
    const float sp = r * (1.0f + r2 * (-1.6666667163e-1f + r2 * (8.3333337680e-3f + r2 * (-1.9841270114e-4f + r2 * 2.7557314297e-6f))));
    const float cp = 1.0f + r2 * (-0.5f + r2 * (4.1666667908e-2f + r2 * (-1.3888889225e-3f + r2 * (2.4801587642e-5f + r2 * -2.7557314297e-7f))));
    const int q = ((int)k) & 3;
    s = (q == 0) ? sp : (q == 1) ? cp : (q == 2) ? -sp : -cp;
    c = (q == 0) ? cp : (q == 1) ? -sp : (q == 2) ? -cp : sp;
}
__device__ __forceinline__ void unpack8(const u32x4 w, float* f) { f[0] = bfl(w.x); f[1] = bfh(w.x); f[2] = bfl(w.y); f[3] = bfh(w.y); f[4] = bfl(w.z); f[5] = bfh(w.z); f[6] = bfl(w.w); f[7] = bfh(w.w); }

#define RLX_AGENT __ATOMIC_RELAXED, __HIP_MEMORY_SCOPE_AGENT
#define XB_TMO      128
#define XB_XCNT(j)  (256  + 64 * (j))
#define XB_XSUB(j)  (1280 + 64 * (j))
#define XB_XGEN(j)  (2304 + 64 * (j))
#define XB_TOP      3328
#define XB_TOPGEN   3392
#define XCD_BAR_WORDS 3456
#define XB_SPIN_CAP (1u << 18)

__device__ __forceinline__ unsigned xb_ld(unsigned* p)              { return __hip_atomic_load(p, __ATOMIC_RELAXED, __HIP_MEMORY_SCOPE_AGENT); }
__device__ __forceinline__ unsigned xb_add(unsigned* p, unsigned v) { return __hip_atomic_fetch_add(p, v, __ATOMIC_RELAXED, __HIP_MEMORY_SCOPE_AGENT); }
__device__ __forceinline__ unsigned xb_xcc_id() { return (unsigned)__builtin_amdgcn_s_getreg((3 << 11) | 20) & 0xFu; }
#define XB_SPIN(cond, bar) do { unsigned _sp = 0; while (cond) { __builtin_amdgcn_s_sleep(1); \
    if ((++_sp & 255u) == 0u) { if (xb_ld(&(bar)[XB_TMO])) break; if (_sp > XB_SPIN_CAP) { atomicAdd(&(bar)[XB_TMO], 1u); break; } } } } while (0)

struct XcdBarrier {
    unsigned* bar; unsigned x;
    volatile LAS unsigned* st;
};

__device__ __forceinline__ XcdBarrier xcd_barrier_post(unsigned* bar, volatile LAS unsigned* st) {
    XcdBarrier b; b.bar = bar; b.x = xb_xcc_id(); b.st = st;
    if (threadIdx.x == 0) (void)xb_add(&bar[XB_XCNT(b.x)], 1u);
    return b;
}
__device__ __forceinline__ void xcd_barrier_complete(unsigned* bar, unsigned x, unsigned& nloc, unsigned& nx) {
    const unsigned G = gridDim.x * gridDim.y * gridDim.z;
    unsigned sum, cnt, mine, sp = 0u;
    for (;;) {
        sum = 0u; cnt = 0u; mine = 0u;
#pragma unroll
        for (unsigned j = 0; j < 16; ++j) { const unsigned c = xb_ld(&bar[XB_XCNT(j)]); sum += c; cnt += (c > 0u) ? 1u : 0u; mine = (j == x) ? c : mine; }
        if (sum == G) break;
        __builtin_amdgcn_s_sleep(1);
        if ((++sp & 255u) == 0u) { if (xb_ld(&bar[XB_TMO])) break; if (sp > XB_SPIN_CAP) { atomicAdd(&bar[XB_TMO], 1u); break; } }
    }
    nloc = mine > 0u ? mine : 1u; nx = cnt > 0u ? cnt : 1u;
}

__device__ __forceinline__ void xcd_barrier(const XcdBarrier& b) {
    asm volatile("s_waitcnt vmcnt(0)" ::: "memory");
    __syncthreads();
    if (threadIdx.x == 0) {
        unsigned* bar = b.bar;
        __builtin_amdgcn_s_waitcnt(0);
        unsigned nloc = b.st[0], nx = b.st[1];
        if (nloc == 0u) { xcd_barrier_complete(bar, b.x, nloc, nx); b.st[0] = nloc; b.st[1] = nx; }
        const unsigned old = xb_add(&bar[XB_XSUB(b.x)], 1u);
        const unsigned gen = old / nloc;
        if (old + 1u == (gen + 1u) * nloc) {
            __builtin_amdgcn_fence(__ATOMIC_RELEASE, "agent");
            asm volatile("s_waitcnt vmcnt(0)" ::: "memory");
            const unsigned og = xb_add(&bar[XB_TOP], 1u);
            const unsigned tg = og / nx;
            if (og + 1u == (tg + 1u) * nx) xb_add(&bar[XB_TOPGEN], 1u);
            else XB_SPIN(xb_ld(&bar[XB_TOPGEN]) == tg, bar);
            __builtin_amdgcn_fence(__ATOMIC_ACQUIRE, "agent");
            xb_add(&bar[XB_XGEN(b.x)], 1u);
            asm volatile("s_waitcnt vmcnt(0)" ::: "memory");
        } else {
            XB_SPIN(xb_ld(&bar[XB_XGEN(b.x)]) == gen, bar);
            __builtin_amdgcn_fence(__ATOMIC_ACQUIRE, "agent");
            asm volatile("s_waitcnt vmcnt(0)" ::: "memory");
        }
    }
    __syncthreads();
}

#define WIN ((bf16*)(ws + WS_WIN))
#define WUQ ((bf16*)(ws + WS_WUQ))
#define WUKV ((bf16*)(ws + WS_WUKV))
#define WM ((bf16*)(ws + WS_WM))
#define WO ((bf16*)(ws + WS_WO))
#define MEMH ((bf16*)(ws + WS_MEMH))
#define MKV ((bf16*)(ws + WS_MKV))
#define COS ((float*)(ws + WS_COS))
#define SIN ((float*)(ws + WS_SIN))
#define SSQ ((float*)(ws + WS_SSQ))
#define SSQX ((float*)(ws + WS_SSQX))
#define KPE ((bf16*)(ws + WS_KPE))
#define H ((bf16*)(ws + WS_HQ))
#define Q ((bf16*)(ws + WS_Q))
#define KV ((bf16*)(ws + WS_KV))
#define Y ((bf16*)(ws + WS_Y))
#define Z ((bf16*)(ws + WS_ZO))
#define O ((bf16*)(ws + WS_ZO))
__global__ void __launch_bounds__(512, 2) fwd_megakernel(Params P_) {
    extern __shared__ __attribute__((aligned(16))) unsigned char lds[];
    cg::grid_group grid = cg::this_grid();
    const int G = gridDim.x, bid = blockIdx.x;

    const int ph_lo = P_.ph_lo, ph_hi = P_.ph_hi;
    volatile LAS unsigned* bst = (volatile LAS unsigned*)((LAS unsigned char*)lds + LDS_MAIN);
    if (threadIdx.x < 2) bst[threadIdx.x] = 0u;
    __syncthreads();
    XcdBarrier xbar; xbar.bar = (unsigned*)P_.ws; xbar.x = xb_xcc_id(); xbar.st = bst;
    if (blockIdx.x == 0) for (unsigned i = threadIdx.x; i < CTL_BYTES / 4; i += 512) ((unsigned*)P_.ws)[i] = 0u;
    for (int p = ph_lo; p < ph_hi; ++p) {
        int tid_l = threadIdx.x; asm volatile("" : "+v"(tid_l));
        const int tid = tid_l, lane = tid & 63, wave = __builtin_amdgcn_readfirstlane(tid >> 6);
        const int gw = bid * 8 + wave, NGW = G * 8; const int gt = bid * 512 + tid, NGT = G * 512;
        const __attribute__((address_space(4))) Params* Pp = (const __attribute__((address_space(4))) Params*)__builtin_amdgcn_kernarg_segment_ptr();
        asm volatile("" : "+s"(Pp));
#define P (*Pp)
        unsigned char* ws = P.ws;
    LAS unsigned char* ldsl = (LAS unsigned char*)lds;
        if (p < NPRO && EN(5)) {
            LAS float* scr = (LAS float*)(ldsl + wave * TR_LDS);
            constexpr int I_IN = 32 * 77, I_UQ = 8 * 24, I_UKV = 4 * 32, I_MK = 32 * 8, I_O = 32 * 32, I_L = I_IN + I_UQ + I_UKV + 2 * I_MK + I_O;
            for (int it = gw; it < DEPTH * I_L; it += NGW) {
                const int l = it / I_L; int r = it % I_L;
                if (r < I_IN) { transpose_item(P.w_in + (size_t)l * DM * INC, P.pre_g + l * DM, DM, INC, WIN + (size_t)l * ZC * DM, 0, 832, 192, scr, r, lane); continue; } r -= I_IN;
                if (r < I_UQ) { transpose_item(P.w_uq + (size_t)l * 512 * QC, P.qn_g + l * 512, 512, QC, WUQ + (size_t)l * QC * 512, 0, 1 << 30, 0, scr, r, lane); continue; } r -= I_UQ;
                if (r < I_UKV) { transpose_item(P.w_ukv + (size_t)l * 256 * KVC, P.kvn_g + l * 256, 256, KVC, WUKV + (size_t)l * KVC * 256, 0, 1 << 30, 0, scr, r, lane); continue; } r -= I_UKV;
                if (r < I_MK) { transpose_item(P.w_mk + (size_t)l * DM * 512, P.memn_g + l * DM, DM, 512, WM + (size_t)l * 1024 * DM, 0, 1 << 30, 0, scr, r, lane); continue; } r -= I_MK;
                if (r < I_MK) { transpose_item(P.w_mv + (size_t)l * DM * 512, P.memn_g + l * DM, DM, 512, WM + (size_t)l * 1024 * DM, 512, 1 << 30, 0, scr, r, lane); continue; } r -= I_MK;
                transpose_item(P.w_o + (size_t)l * DM * DM, nullptr, DM, DM, WO + (size_t)l * DM * DM, 0, 1 << 30, 0, scr, r, lane);
            }
            for (int i = gt; i < DEPTH * 192 * DM / 8; i += NGT) { const int l = i / (192 * DM / 8); const int j = i % (192 * DM / 8);
                *(u32x4*)(WIN + (size_t)l * ZC * DM + (size_t)832 * DM + (size_t)j * 8) = (u32x4){0u, 0u, 0u, 0u}; }
            for (int m = gw; m < T; m += NGW) cvt_row(P.x + (size_t)m * DM, H + (size_t)m * DM, SSQX + m, lane);
            for (int m = gw; m < MROWS; m += NGW) prenorm_row(P.mem + (size_t)m * DM, nullptr, MEMH + (size_t)m * DM, lane);
            for (int i = gt; i < T * 32; i += NGT) { const int row = i >> 5, j = i & 31;
                const float ang = (float)P.pos[row] * P.inv_freq[j]; float s, c; sincos_acc(ang, s, c); COS[i] = c; SIN[i] = s; }
        } else {
            const int l = (p - NPRO) / SLOTS, sk = (p - NPRO) % SLOTS, st = (MK_DUP == 6) ? sk : (MK_DUP >= 0 && sk > MK_DUP) ? sk - 1 : sk;
            if (st == 0 && EN(0)) {
                if (l == 0) { pg8::Gemm g{MEMH, WM, MROWS, MKVC, DM, DM}; pg8::StaticOrder S; S.init(MROWS, MKVC, G, bid);
                    pg8::EpiRow E{MKV, MKVC, nullptr, 0, 0, 0.f}; pg8::gemm_phase<pg8::EpiRow, pg8::StaticOrder, true, true>(ldsl, g, S, E); }
                pg8::Gemm g{H, WIN + (size_t)l * ZC * DM, T, ZC, DM, DM}; pg8::StaticOrder S; S.init(T, ZC, G, bid);
                pg8::EpiZ E{Z, SSQ, SSQX, ZC, ZO_GATE / 256, 3}; pg8::gemm_phase<pg8::EpiZ, pg8::StaticOrder, true, true>(ldsl, g, S, E);
            } else if (st == 1 && EN(1)) {
                for (int i = gt; i < T * 8; i += NGT) { const int row = i >> 3, j = i & 7;
                    const u32x2 a = *(const u32x2*)(Z + (size_t)row * ZC + ZO_KPE + j * 4), b = *(const u32x2*)(Z + (size_t)row * ZC + ZO_KPE + 32 + j * 4);
                    const f32x4 c = *(const f32x4*)(COS + (size_t)row * 32 + j * 4), s = *(const f32x4*)(SIN + (size_t)row * 32 + j * 4);
                    const float x1[4] = {bfl(a.x), bfh(a.x), bfl(a.y), bfh(a.y)}, x2[4] = {bfl(b.x), bfh(b.x), bfl(b.y), bfh(b.y)};
                    float o1[4], o2[4];
#pragma unroll
                    for (int e = 0; e < 4; ++e) { o1[e] = x1[e] * c[e] - x2[e] * s[e]; o2[e] = x2[e] * c[e] + x1[e] * s[e]; }
                    *(u32x2*)(KPE + (size_t)row * 64 + j * 4) = (u32x2){pk2(o1[0], o1[1]), pk2(o1[2], o1[3])};
                    *(u32x2*)(KPE + (size_t)row * 64 + 32 + j * 4) = (u32x2){pk2(o2[0], o2[1]), pk2(o2[2], o2[3])}; }
                const float* cw = P.conv_w + (size_t)l * 3 * 512;
                for (int i = gt; i < (T / 4) * 64; i += NGT) { const int row0 = (i >> 6) * 4, c8 = (i & 63) * 8, sp0 = row0 & (SEQ - 1);
                    const bf16* zr = Z + (size_t)row0 * ZC;
                    const bool hb = sp0 > 0, ha = sp0 + 4 < SEQ;
                    u32x4 gcr[6], xir[6], gbr[4], sgr[4];
#pragma unroll
                    for (int r = 0; r < 6; ++r) { const int rr = (r == 0 && !hb) ? 0 : (r == 5 && !ha) ? 3 : r - 1;
                        gcr[r] = __builtin_nontemporal_load((const u32x4*)(zr + (long)rr * ZC + ZO_GC + c8)); xir[r] = __builtin_nontemporal_load((const u32x4*)(zr + (long)rr * ZC + ZO_XIN + c8)); }
#pragma unroll
                    for (int r = 0; r < 4; ++r) { gbr[r] = __builtin_nontemporal_load((const u32x4*)(zr + (long)r * ZC + ZO_GB + c8)); sgr[r] = __builtin_nontemporal_load((const u32x4*)(zr + (long)r * ZC + ZO_GATE + 1024 + c8)); }
                    float w0[8], w1[8], w2[8];
#pragma unroll
                    for (int e = 0; e < 8; ++e) { w0[e] = cw[c8 + e]; w1[e] = cw[512 + c8 + e]; w2[e] = cw[1024 + c8 + e]; }
                    float u[6][8];
#pragma unroll
                    for (int r = 0; r < 6; ++r) { float a[8], b[8]; unpack8(gcr[r], a); unpack8(xir[r], b); const float keep = ((r == 0 && !hb) || (r == 5 && !ha)) ? 0.f : 1.f;
#pragma unroll
                        for (int e = 0; e < 8; ++e) u[r][e] = a[e] * b[e] * keep; }
#pragma unroll
                    for (int r = 0; r < 4; ++r) { float gb[8], sg[8], o[8]; unpack8(gbr[r], gb); unpack8(sgr[r], sg);
#pragma unroll
                        for (int e = 0; e < 8; ++e) o[e] = gb[e] * (u[r][e] * w0[e] + u[r + 1][e] * w1[e] + u[r + 2][e] * w2[e]) * sg[e];
                        *(u32x4*)(Y + (size_t)(row0 + r) * DM + 1024 + c8) = (u32x4){pk2(o[0], o[1]), pk2(o[2], o[3]), pk2(o[4], o[5]), pk2(o[6], o[7])}; }
                }
                { pg8::Gemm g{Z + ZO_QLAT, WUQ + (size_t)l * QC * 512, T, QC, 512, ZC}; pg8::StaticOrder S; S.init(T, QC, G, bid);
                  pg8::EpiRow E{Q, QC, SSQ, 0, 8, 1.0f / 512}; pg8::gemm_phase<pg8::EpiRow, pg8::StaticOrder, true, false>(ldsl, g, S, E); }
                { pg8::Gemm g{Z + ZO_KVLAT, WUKV + (size_t)l * KVC * 256, T, KVC, 256, ZC}; pg8::StaticOrder S; S.init(T, KVC, G, bid);
                  pg8::EpiRow E{KV, KVC, SSQ, 8, 4, 1.0f / 256}; pg8::gemm_phase<pg8::EpiRow, pg8::StaticOrder, true, false>(ldsl, g, S, E); }
            } else if (st == 2 && EN(2)) {
                const int vcu = (G % 8 == 0) ? (bid % 8) * (G / 8) + bid / 8 : bid;
                for (int idx = vcu; idx < 1536; idx += G) {
                    if (idx < 1024 && EN(6)) { const int bh = idx >> 4, qb = idx & 15, b = bh >> 3, h = bh & 7; const size_t row0 = (size_t)b * SEQ + qb * 256, kr0 = (size_t)b * SEQ;
                        att::attn_body<true, QC, KVC, ZC, DM>(Q + row0 * QC + h * 192, KV + kr0 * KVC + h * 256, KV + kr0 * KVC + h * 256 + 128, KPE + kr0 * 64,
                            COS + row0 * 32, SIN + row0 * 32, Z + row0 * ZC + ZO_GATE + h * 128, Y + row0 * DM + h * 128, SEQ, (char*)lds);
                    } else if (EN(7)) { const int j = idx - 1024, bh = j >> 4, qb = j & 15, b = bh >> 2, h = bh & 3; const size_t row0 = (size_t)b * SEQ + qb * 256, kr0 = (size_t)b * MEMT;
                        att::attn_body<false, ZC, MKVC, ZC, DM>(Z + row0 * ZC + ZO_QMEM + h * 128, MKV + kr0 * MKVC + l * 1024 + h * 128, MKV + kr0 * MKVC + l * 1024 + 512 + h * 128, nullptr,
                            nullptr, nullptr, Z + row0 * ZC + ZO_GATE + 1536 + h * 128, Y + row0 * DM + 1536 + h * 128, MEMT, (char*)lds);
                    }
                }
            } else if (st == 3 && EN(3)) {
                pg8::Gemm g{Y, WO + (size_t)l * DM * DM, T, DM, DM, DM}; pg8::StaticOrder S; S.init(T, DM, G, bid);
                pg8::EpiRow E{O, DM, nullptr, 0, 0, 0.f}; pg8::gemm_phase<pg8::EpiRow, pg8::StaticOrder, true, true>(ldsl, g, S, E);
            } else if (EN(4)) {
                const float* gpost = P.post_g + l * DM; const bool last = (l + 1 == DEPTH); float* outp = P.out;
                for (int m = gw; m < T; m += 2 * NGW) { const int m2 = m + NGW, mc = m2 < T ? m2 : m; RowIn Ra, Rb;
                    post_load(Ra, H + (size_t)m * DM, O + (size_t)m * DM, lane);
                    post_load(Rb, H + (size_t)mc * DM, O + (size_t)mc * DM, lane);
                    post_finish(Ra, gpost, last, outp + (size_t)m * DM, H + (size_t)m * DM, SSQX + m, lane);
                    if (m2 < T) post_finish(Rb, gpost, last, outp + (size_t)m2 * DM, H + (size_t)m2 * DM, SSQX + m2, lane); }
            }
        }
        if (p + 1 < ph_hi) { if (p == ph_lo) { grid.sync(); if (threadIdx.x == 0) (void)xb_add(&xbar.bar[XB_XCNT(xbar.x)], 1u); } else xcd_barrier(xbar); }
#undef P
    }
}

#undef WIN
#undef WUQ
#undef WUKV
#undef WM
#undef WO
#undef MEMH
#undef MKV
#undef COS
#undef SIN
#undef SSQ
#undef SSQX
#undef KPE
#undef H
#undef Q
#undef KV
#undef Y
#undef Z
#undef O
#ifndef MK_MULTI
#define MK_MULTI 0
#endif
extern "C" void kernel_launch(void* const* d_in, const int* in_sizes, int n_in, void* d_out, int out_size, void* d_ws, size_t ws_size, hipStream_t stream) {
    static int grid = 0;
    if (grid == 0) {
        if (n_in != 15 || in_sizes[0] != T * DM || out_size != T * DM || ws_size < WS_END) { fprintf(stderr, "kernel_launch: unexpected shapes (n_in %d in0 %d out %d ws %zu)\n", n_in, n_in > 0 ? in_sizes[0] : -1, out_size, ws_size); grid = -1; return; }
        int dev = 0, cus = 0, per_cu = 0;
        hipGetDevice(&dev); hipDeviceGetAttribute(&cus, hipDeviceAttributeMultiprocessorCount, dev);
        if (hipFuncSetAttribute((const void*)fwd_megakernel, hipFuncAttributeMaxDynamicSharedMemorySize, LDS_BYTES) != hipSuccess) { fprintf(stderr, "kernel_launch: hipFuncSetAttribute failed\n"); grid = -1; return; }
        if (hipOccupancyMaxActiveBlocksPerMultiprocessor(&per_cu, (const void*)fwd_megakernel, 512, LDS_BYTES) != hipSuccess || per_cu < 1) { fprintf(stderr, "kernel_launch: occupancy query says %d\n", per_cu); per_cu = 1; }
        (void)hipGetLastError();
        grid = cus * 1;
        fprintf(stderr, "kernel_launch: grid %d (cus %d, per_cu %d), ws %zu\n", grid, cus, per_cu, ws_size);
    }
    if (grid < 0) return;
    Params p{};
    p.x = (const float*)d_in[0]; p.mem = (const float*)d_in[1]; p.pos = (const int*)d_in[2]; p.pre_g = (const float*)d_in[3]; p.w_in = (const float*)d_in[4];
    p.qn_g = (const float*)d_in[5]; p.w_uq = (const float*)d_in[6]; p.kvn_g = (const float*)d_in[7]; p.w_ukv = (const float*)d_in[8]; p.conv_w = (const float*)d_in[9];
    p.memn_g = (const float*)d_in[10]; p.w_mk = (const float*)d_in[11]; p.w_mv = (const float*)d_in[12]; p.w_o = (const float*)d_in[13]; p.post_g = (const float*)d_in[14];
    p.out = (float*)d_out; p.ws = (unsigned char*)d_ws;
    for (int j = 0; j < 32; ++j) p.inv_freq[j] = 1.0f / powf(10000.0f, (float)(2 * j) / 64.0f);
#if MK_MULTI
    for (int ph = 0; ph < NPHASE; ++ph) { p.ph_lo = ph; p.ph_hi = ph + 1; hipLaunchKernelGGL(fwd_megakernel, dim3(grid), dim3(512), LDS_BYTES, stream, p); }
#else
    p.ph_lo = 0; p.ph_hi = NPHASE; void* args[] = {&p};
    hipError_t e = hipLaunchCooperativeKernel((const void*)fwd_megakernel, dim3(grid), dim3(512), args, LDS_BYTES, stream);
    if (e != hipSuccess) fprintf(stderr, "kernel_launch: cooperative launch failed: %s (grid %d)\n", hipGetErrorString(e), grid);
#endif
}
static_assert(att::LDS_BYTES <= LDS_MAIN, "attention LDS");
```

```cpp
#include <hip/hip_runtime.h>
#include <hip/hip_cooperative_groups.h>
#include <cstdio>
#include <cstdint>
#include <cmath>
namespace cg = cooperative_groups;
namespace pg8 {
#define PG8_LAS __attribute__((address_space(3)))
typedef unsigned short bf16_t;
typedef short bf16x8 __attribute__((ext_vector_type(8)));
typedef float f32x4 __attribute__((ext_vector_type(4)));
typedef unsigned u32x4 __attribute__((ext_vector_type(4)));
constexpr int BM = 256, BK = 64, HALF = 128, HTB = HALF * BK * 2  , STAGE_BYTES = 8 * HTB, NXCD = 8, WGM = 8;

__host__ __device__ __forceinline__ int lds_byte(int r, int c) { const int st = (r >> 4) * 2 + (c >> 5), rr = r & 15, cc = c & 31, ob = rr * 64 + cc * 2; return st * 1024 + (ob ^ (((ob >> 9) & 1) << 5)); }
__host__ __device__ __forceinline__ void stage_rc(int b, int& R, int& C) { const int st = b / 1024, sb = b % 1024, swz = sb ^ (((sb >> 9) & 1) << 5); R = (st >> 1) * 16 + swz / 64; C = (st & 1) * 32 + (swz % 64) / 2; }
__host__ __device__ __forceinline__ int perm32(int rho) { const int n = rho >> 4, i = rho & 15; return 8 * (i >> 2) + 4 * n + (i & 3); }

struct Unit { int pm, pn; };
struct Gemm { const bf16_t* A; const bf16_t* Bt; int M, N, K, lda; };

struct StaticOrder {
    int nM, nN, nwg, G, c;
    __host__ __device__ void init(int M, int N, int G_, int c_) { nM = M / BM; nN = N / BM; nwg = nM * nN; G = G_; c = c_; }
    __host__ __device__ bool next(int i, Unit& u) const {
        const long L = (long)i * G + c; if (L >= nwg) return false;
        int wgid = (int)L; { const int q = nwg / NXCD, r = nwg % NXCD, xcd = wgid % NXCD, off = wgid / NXCD; wgid = (xcd < r ? xcd * (q + 1) : r * (q + 1) + (xcd - r) * q) + off; }
        const int nig = WGM * nN, gid = wgid / nig, fm = gid * WGM, gsz = (nM - fm) < WGM ? (nM - fm) : WGM;
        u.pm = fm + ((wgid % nig) % gsz); u.pn = (wgid % nig) / gsz; return true;
    }
    __device__ __forceinline__ void a_ready(const Unit&) const {}
    __device__ __forceinline__ void done(const Unit&) const {}
};
__device__ __forceinline__ unsigned cvt_pk_bf16(float lo, float hi) { unsigned r; asm volatile("v_cvt_pk_bf16_f32 %0, %1, %2" : "=v"(r) : "v"(lo), "v"(hi)); return r; }
typedef float f32x2 __attribute__((ext_vector_type(2)));
__device__ __forceinline__ f32x4 silu4(f32x4 v) {
    f32x4 r;
#pragma unroll
    for (int i = 0; i < 4; ++i) r[i] = v[i] * __builtin_amdgcn_rcpf(1.0f + __builtin_amdgcn_exp2f(-1.4426950408889634f * v[i]));
    return r;
}
__device__ __forceinline__ void st_bf16x8(bf16_t* p, f32x4 v0, f32x4 v1) {
    u32x4 w; w.x = cvt_pk_bf16(v0[0], v0[1]); w.y = cvt_pk_bf16(v0[2], v0[3]); w.z = cvt_pk_bf16(v1[0], v1[1]); w.w = cvt_pk_bf16(v1[2], v1[3]);
    *(u32x4*)p = w;
}
struct EpiZ {
    static constexpr bool PERM = true, AFTER_DRAIN = false;
    bf16_t* Z; float* ssq; const float* ssqx; int ldc, silu_from, ssq_to;
    __device__ __forceinline__ void operator()(const f32x4 (&acc)[2][2][4][2], const Unit& u, int wr, int wc, int fr, int fq) const {
        int frq = fr; asm volatile("" : "+v"(frq));
        const int row0 = u.pm * BM + wr * 64 + frq, col0 = u.pn * BM + wc * 32 + 8 * fq;
        const bool do_silu = u.pn >= silu_from, do_ssq = u.pn < ssq_to;
        if (u.pn == ssq_to && wc >= 2) return;
        const int nbj = (u.pn == ssq_to) ? 1 : 2;
        float rsv[2][4];
#pragma unroll
        for (int ai = 0; ai < 2; ++ai)
#pragma unroll
            for (int m = 0; m < 4; ++m) rsv[ai][m] = ssqx[row0 + ai * HALF + m * 16];
#pragma unroll
        for (int ai = 0; ai < 2; ++ai)
#pragma unroll
            for (int m = 0; m < 4; ++m) rsv[ai][m] = 1.0f / sqrtf(rsv[ai][m] * (1.0f / 2048.0f) + 1e-6f);
        __builtin_amdgcn_sched_barrier(0);
#pragma unroll
        for (int ai = 0; ai < 2; ++ai)
#pragma unroll
            for (int m = 0; m < 4; ++m) { const int row = row0 + ai * HALF + m * 16; bf16_t* rowp = Z + (size_t)row * ldc + col0; float s = 0.f;
                const float rs = rsv[ai][m];
#pragma unroll
                for (int bj = 0; bj < 2; ++bj) { if (bj >= nbj) break; f32x4 v0 = acc[ai][bj][m][0] * rs, v1 = acc[ai][bj][m][1] * rs;
                    if (do_silu) { v0 = silu4(v0); v1 = silu4(v1); }
                    if (do_ssq) s += (v0[0] * v0[0] + v0[1] * v0[1]) + (v0[2] * v0[2] + v0[3] * v0[3]) + (v1[0] * v1[0] + v1[1] * v1[1]) + (v1[2] * v1[2] + v1[3] * v1[3]);
                    st_bf16x8(rowp + bj * HALF, v0, v1); }
                if (do_ssq) { s += __shfl_xor(s, 16); s += __shfl_xor(s, 32); if (fq == 0) ssq[(size_t)row * 12 + u.pn * 4 + wc] = s; }
                __builtin_amdgcn_sched_barrier(0); }
    }
};
struct EpiRow {
    static constexpr bool PERM = true, AFTER_DRAIN = false;
    bf16_t* O; int ldc; const float* ssq; int s0, ns; float invk;
    __device__ __forceinline__ void operator()(const f32x4 (&acc)[2][2][4][2], const Unit& u, int wr, int wc, int fr, int fq) const {
        int frq = fr; asm volatile("" : "+v"(frq));
        const int row0 = u.pm * BM + wr * 64 + frq, col0 = u.pn * BM + wc * 32 + 8 * fq;
        float scv[2][4];
        if (ns) {
            f32x4 t0[2][4], t1[2][4];
#pragma unroll
            for (int ai = 0; ai < 2; ++ai)
#pragma unroll
                for (int m = 0; m < 4; ++m) { const float* sp = ssq + (size_t)(row0 + ai * HALF + m * 16) * 12 + s0; t0[ai][m] = *(const f32x4*)sp; t1[ai][m] = (ns > 4) ? *(const f32x4*)(sp + 4) : (f32x4){0.f, 0.f, 0.f, 0.f}; }
#pragma unroll
            for (int ai = 0; ai < 2; ++ai)
#pragma unroll
                for (int m = 0; m < 4; ++m) { const f32x4 a = t0[ai][m], b = t1[ai][m]; const float t = ((a[0] + a[1]) + (a[2] + a[3])) + ((b[0] + b[1]) + (b[2] + b[3])); scv[ai][m] = 1.0f / sqrtf(t * invk + 1e-6f); }
        } else {
#pragma unroll
            for (int ai = 0; ai < 2; ++ai)
#pragma unroll
                for (int m = 0; m < 4; ++m) scv[ai][m] = 1.f;
        }
        __builtin_amdgcn_sched_barrier(0);
#pragma unroll
        for (int ai = 0; ai < 2; ++ai)
#pragma unroll
            for (int m = 0; m < 4; ++m) { const int row = row0 + ai * HALF + m * 16; bf16_t* rowp = O + (size_t)row * ldc + col0; const float sc = scv[ai][m];
#pragma unroll
                for (int bj = 0; bj < 2; ++bj) st_bf16x8(rowp + bj * HALF, acc[ai][bj][m][0] * sc, acc[ai][bj][m][1] * sc);
                __builtin_amdgcn_sched_barrier(0); }
    }
};
template <class Epi, class Sched, bool ALIGN_EPI = false, bool SP2 = false>
__device__ __forceinline__ void gemm_phase(PG8_LAS unsigned char* lds, const Gemm g, const Sched& S, const Epi& E) {
    int tid_l = threadIdx.x; asm volatile("" : "+v"(tid_l));
    const int tid = tid_l, wid = __builtin_amdgcn_readfirstlane(tid >> 6), lane = tid & 63, wr = wid >> 2, wc = wid & 3, fr = lane & 15, fq = lane >> 4;
    const int K = g.K, nt = K / BK;
    unsigned voffA[2], voffB[2];
#pragma unroll
    for (int i = 0; i < 2; ++i) { int R, C; stage_rc(tid * 16 + i * 8192, R, C); const int Rb = Epi::PERM ? ((R & ~31) + perm32(R & 31)) : R;
        voffA[i] = (unsigned)(R * g.lda + C) * 2u; voffB[i] = (unsigned)(Rb * K + C) * 2u; }
    const size_t kstep = (size_t)(BK * 2);
    const size_t hstepB = (size_t)HALF * K * 2, hstepA = (size_t)HALF * g.lda * 2;
    const size_t tstepB = 2 * hstepB, tstepA = 2 * hstepA;
    const unsigned ldsw = (unsigned)wid * 1024u;
    const int aoff = lds_byte(wr * 64 + fr, fq * 8), boff = lds_byte(wc * 32 + fr, fq * 8);
#define PG8_SA(b, h) (((b) * 2 + (h)) * HTB)
#define PG8_SB(b, h) ((4 + (b) * 2 + (h)) * HTB)
#define PG8_STAGE(bufoff, gbase, voff) do { _Pragma("unroll") for (int _i = 0; _i < 2; ++_i) \
        __builtin_amdgcn_global_load_lds((const unsigned*)((const char*)(gbase) + (voff)[_i]), (PG8_LAS unsigned*)(lds + (bufoff) + ldsw + _i * 8192), 16, 0, 0); } while (0)
#define PG8_LDA(dst, b, h) do { _Pragma("unroll") for (int m = 0; m < 4; ++m) _Pragma("unroll") for (int k = 0; k < 2; ++k) dst[m][k] = *(const PG8_LAS bf16x8*)(lds + PG8_SA(b, h) + aoff + m * 2048 + k * 1024); } while (0)
#define PG8_LDB(dst, b, h) do { _Pragma("unroll") for (int n = 0; n < 2; ++n) _Pragma("unroll") for (int k = 0; k < 2; ++k) dst[n][k] = *(const PG8_LAS bf16x8*)(lds + PG8_SB(b, h) + boff + n * 2048 + k * 1024); } while (0)
#define PG8_MMA(ai, bj, At, Bt) do { __builtin_amdgcn_s_setprio(1); _Pragma("unroll") for (int m = 0; m < 4; ++m) _Pragma("unroll") for (int n = 0; n < 2; ++n) _Pragma("unroll") for (int k = 0; k < 2; ++k) \
        acc[ai][bj][m][n] = __builtin_amdgcn_mfma_f32_16x16x32_bf16(Bt[n][k], At[m][k], acc[ai][bj][m][n], 0, 0, 0); __builtin_amdgcn_s_setprio(0); } while (0)
#define PG8_WAIT_V(n) asm volatile("s_waitcnt vmcnt(" #n ")" ::: "memory")
#define PG8_WAIT_L(n) asm volatile("s_waitcnt lgkmcnt(" #n ")" ::: "memory")
#define PG8_BAR __builtin_amdgcn_s_barrier()
#define PG8_SCHED __builtin_amdgcn_sched_barrier(0)
    Unit cur, nxt; int ui = 0;
    if (!S.next(0, cur)) return;
    f32x4 acc[2][2][4][2];
#pragma unroll
    for (int a = 0; a < 2; ++a)
#pragma unroll
        for (int b = 0; b < 2; ++b)
#pragma unroll
            for (int m = 0; m < 4; ++m)
#pragma unroll
                for (int n = 0; n < 2; ++n) acc[a][b][m][n] = (f32x4){0.f, 0.f, 0.f, 0.f};
    bf16x8 At[4][2], B0[2][2], B1[2][2];
    const char* cA = (const char*)g.A + (size_t)cur.pm * tstepA; const char* cB = (const char*)g.Bt + (size_t)cur.pn * tstepB;
    S.a_ready(cur);
    if constexpr (SP2) {
        PG8_STAGE(PG8_SB(0, 0), cB, voffB); PG8_STAGE(PG8_SB(0, 1), cB + hstepB, voffB); PG8_STAGE(PG8_SA(0, 0), cA, voffA); PG8_STAGE(PG8_SA(0, 1), cA + hstepA, voffA);
        if (wr == 1) PG8_BAR;
        PG8_WAIT_V(2); PG8_BAR;
        PG8_STAGE(PG8_SB(1, 0), cB + kstep, voffB); PG8_STAGE(PG8_SA(1, 0), cA + kstep, voffA); PG8_STAGE(PG8_SB(1, 1), cB + hstepB + kstep, voffB);
        PG8_WAIT_V(6); PG8_BAR;
    } else {
        PG8_STAGE(PG8_SB(0, 0), cB, voffB); PG8_STAGE(PG8_SA(0, 0), cA, voffA); PG8_STAGE(PG8_SB(0, 1), cB + hstepB, voffB); PG8_STAGE(PG8_SA(0, 1), cA + hstepA, voffA);
        if (wr == 1) PG8_BAR;
        PG8_WAIT_V(4); PG8_BAR;
        PG8_STAGE(PG8_SB(1, 0), cB + kstep, voffB); PG8_STAGE(PG8_SA(1, 0), cA + kstep, voffA); PG8_STAGE(PG8_SB(1, 1), cB + hstepB + kstep, voffB);
        PG8_WAIT_V(6); PG8_BAR;
    }
    for (;;) {
        const bool has_next = S.next(ui + 1, nxt);
        const char* nA = has_next ? (const char*)g.A + (size_t)nxt.pm * tstepA : cA; const char* nB = has_next ? (const char*)g.Bt + (size_t)nxt.pn * tstepB : cB;
        for (int t = 0; t < nt; t += 2) {
            const bool last = (t == nt - 2);
            const char* a1 = cA + (size_t)(t + 1) * kstep;
            const char* a2 = last ? nA : cA + (size_t)(t + 2) * kstep; const char* b2 = last ? nB : cB + (size_t)(t + 2) * kstep;
            const char* a3 = a2 + kstep; const char* b3 = b2 + kstep;
            if (last && has_next) S.a_ready(nxt);
            if constexpr (SP2) {
            PG8_LDB(B0, 0, 0); PG8_LDB(B1, 0, 1); PG8_SCHED; PG8_LDA(At, 0, 0); PG8_STAGE(PG8_SA(1, 1), a1 + hstepA, voffA);
            PG8_WAIT_V(8); PG8_WAIT_L(0); PG8_BAR; PG8_MMA(0, 0, At, B0); PG8_MMA(0, 1, At, B1); PG8_BAR; PG8_SCHED;
            PG8_LDA(At, 0, 1); PG8_STAGE(PG8_SB(0, 0), b2, voffB); PG8_STAGE(PG8_SB(0, 1), b2 + hstepB, voffB); PG8_STAGE(PG8_SA(0, 0), a2, voffA);
            PG8_WAIT_V(8); PG8_WAIT_L(0); PG8_BAR; PG8_MMA(1, 0, At, B0); PG8_MMA(1, 1, At, B1); PG8_BAR; PG8_SCHED;
            PG8_LDB(B0, 1, 0); PG8_LDB(B1, 1, 1); PG8_SCHED; PG8_LDA(At, 1, 0); PG8_STAGE(PG8_SA(0, 1), a2 + hstepA, voffA);
            PG8_WAIT_V(8); PG8_WAIT_L(0); PG8_BAR; PG8_MMA(0, 0, At, B0); PG8_MMA(0, 1, At, B1); PG8_BAR; PG8_SCHED;
            PG8_LDA(At, 1, 1); PG8_STAGE(PG8_SB(1, 0), b3, voffB); PG8_STAGE(PG8_SB(1, 1), b3 + hstepB, voffB); PG8_STAGE(PG8_SA(1, 0), a3, voffA);
            PG8_WAIT_V(8); PG8_WAIT_L(0); PG8_BAR; PG8_MMA(1, 0, At, B0); PG8_MMA(1, 1, At, B1); PG8_BAR; PG8_SCHED;
            } else {
            PG8_LDB(B0, 0, 0); PG8_SCHED; PG8_LDA(At, 0, 0); PG8_STAGE(PG8_SA(1, 1), a1 + hstepA, voffA);
            PG8_WAIT_L(8); PG8_BAR; PG8_WAIT_L(0); PG8_MMA(0, 0, At, B0); PG8_BAR; PG8_SCHED;
            PG8_LDB(B1, 0, 1); PG8_STAGE(PG8_SB(0, 0), b2, voffB);
            PG8_BAR; PG8_WAIT_L(0); PG8_MMA(0, 1, At, B1); PG8_BAR;
            PG8_LDA(At, 0, 1); PG8_STAGE(PG8_SA(0, 0), a2, voffA);
            PG8_BAR; PG8_WAIT_L(0); PG8_MMA(1, 0, At, B0); PG8_BAR; PG8_SCHED;
            PG8_STAGE(PG8_SB(0, 1), b2 + hstepB, voffB);
            PG8_WAIT_V(6); PG8_BAR; PG8_MMA(1, 1, At, B1); PG8_BAR;
            PG8_LDB(B0, 1, 0); PG8_SCHED; PG8_LDA(At, 1, 0); PG8_STAGE(PG8_SA(0, 1), a2 + hstepA, voffA);
            PG8_WAIT_L(8); PG8_BAR; PG8_WAIT_L(0); PG8_MMA(0, 0, At, B0); PG8_BAR; PG8_SCHED;
            PG8_LDB(B1, 1, 1); PG8_STAGE(PG8_SB(1, 0), b3, voffB);
            PG8_BAR; PG8_WAIT_L(0); PG8_MMA(0, 1, At, B1); PG8_BAR;
            PG8_LDA(At, 1, 1); PG8_STAGE(PG8_SA(1, 0), a3, voffA);
            PG8_BAR; PG8_WAIT_L(0); PG8_MMA(1, 0, At, B0); PG8_BAR; PG8_SCHED;
            PG8_STAGE(PG8_SB(1, 1), b3 + hstepB, voffB);
            PG8_WAIT_V(6); PG8_BAR; PG8_MMA(1, 1, At, B1); PG8_BAR;
            }
        }
        if constexpr (ALIGN_EPI) { if (wr == 0) PG8_BAR; }
        if constexpr (!Epi::AFTER_DRAIN) { E(acc, cur, wr, wc, fr, fq); S.done(cur); }
        if (!has_next) break;
#pragma unroll
        for (int a = 0; a < 2; ++a)
#pragma unroll
            for (int b = 0; b < 2; ++b)
#pragma unroll
                for (int m = 0; m < 4; ++m)
#pragma unroll
                    for (int n = 0; n < 2; ++n) acc[a][b][m][n] = (f32x4){0.f, 0.f, 0.f, 0.f};
        cur = nxt; cA = nA; cB = nB; ++ui;
        if constexpr (ALIGN_EPI) { if (wr == 1) PG8_BAR; }
    }
    PG8_WAIT_V(0);
    if constexpr (!ALIGN_EPI) { if (wr == 0) PG8_BAR; }
    PG8_BAR;
    if constexpr (Epi::AFTER_DRAIN) { E.fused(acc, cur, wr, wc, fr, fq, lds, wid, lane); S.done(cur); }
#undef PG8_SA
#undef PG8_SB
#undef PG8_STAGE
#undef PG8_LDA
#undef PG8_LDB
#undef PG8_MMA
#undef PG8_WAIT_V
#undef PG8_WAIT_L
#undef PG8_BAR
#undef PG8_SCHED
}
}
namespace att {
typedef unsigned short bf16;
using bf16x8 = __attribute__((ext_vector_type(8))) short;
using s16x4  = __attribute__((ext_vector_type(4))) short;
using f32x16 = __attribute__((ext_vector_type(16))) float;
using f32x4  = __attribute__((ext_vector_type(4))) float;
using u32x4  = __attribute__((ext_vector_type(4))) unsigned;
constexpr int NW = 8, QBLK = 32, KVBLK = 64;
constexpr int SHM_V = 16384, SHM_K = 16384, SHM_KR = 8192;
constexpr int NVBUF = 3;
constexpr int OFF_V = 0, OFF_K = NVBUF * SHM_V, OFF_KR = OFF_K + 2 * SHM_K, OFF_WS = OFF_KR + 2 * SHM_KR, OFF_QR = OFF_WS + NW * 64 * 4, LDS_BYTES = OFF_QR + NW * 4096;
constexpr float THR = 8.f;
#define KSWZ(row, colB) ((row) * 256 + ((colB) ^ (((row) & 15) << 4)))
#define KRSWZ(row, colB) ((row) * 128 + ((colB) ^ ((((row) >> 1) & 7) << 4)))
#define SBAR() __builtin_amdgcn_sched_barrier(0)
__device__ __forceinline__ int crow(int r, int hi) { return (r & 3) + 8 * (r >> 2) + 4 * hi; }
__device__ __forceinline__ unsigned cvtpk(float lo, float hi) { unsigned r; asm volatile("v_cvt_pk_bf16_f32 %0, %1, %2" : "=v"(r) : "v"(lo), "v"(hi)); return r; }
__device__ __forceinline__ float bf2f(short s) { return __uint_as_float(((unsigned)(unsigned short)s) << 16); }
template <bool MLA> struct Sc { static constexpr float SCALE = MLA ? 0.07216878364870322f : 0.08838834764831845f; };

template <bool MLA> __device__ __forceinline__ void partialSM(f32x16& p0, f32x16& p1, float& m_reg, float& mn, float& alpha) {
  constexpr float SCALE = Sc<MLA>::SCALE; constexpr float C = SCALE * 1.4426950408889634f;
  float pmax = p0[0]; for (int r = 1; r < 16; ++r) pmax = fmaxf(pmax, p0[r]); for (int r = 0; r < 16; ++r) pmax = fmaxf(pmax, p1[r]);
  { auto rr = __builtin_amdgcn_permlane32_swap(__float_as_uint(pmax), __float_as_uint(pmax), false, false);
    pmax = fmaxf(__uint_as_float(rr[0]), __uint_as_float(rr[1])); }
  if (__builtin_expect(__all(pmax - m_reg <= THR / SCALE), 1)) { mn = m_reg; alpha = 1.f; }
  else { mn = fmaxf(m_reg, pmax); alpha = __builtin_amdgcn_exp2f((m_reg - mn) * C); m_reg = mn; }
  float mnC = -mn * C;
  for (int r = 0; r < 16; ++r) p0[r] = fmaf(p0[r], C, mnC); for (int r = 0; r < 16; ++r) p1[r] = fmaf(p1[r], C, mnC);
  for (int r = 0; r < 16; ++r) p0[r] = __builtin_amdgcn_exp2f(p0[r]);
}
__device__ __forceinline__ void finishSM(f32x16& p0, f32x16& p1, float alpha, float& l_reg, bf16x8& pa0, bf16x8& pa1, bf16x8& pa2, bf16x8& pa3) {
  for (int r = 0; r < 16; ++r) p1[r] = __builtin_amdgcn_exp2f(p1[r]);
  float ps = 0; for (int r = 0; r < 16; ++r) ps += p0[r]; for (int r = 0; r < 16; ++r) ps += p1[r];
  { auto rr = __builtin_amdgcn_permlane32_swap(__float_as_uint(ps), __float_as_uint(ps), false, false);
    ps = __uint_as_float(rr[0]) + __uint_as_float(rr[1]); }
  l_reg = l_reg * alpha + ps;
#define PK4(P, BASE, OUT) do { unsigned a0 = cvtpk(P[BASE + 0], P[BASE + 1]), a1 = cvtpk(P[BASE + 2], P[BASE + 3]);   \
    unsigned b0 = cvtpk(P[BASE + 4], P[BASE + 5]), b1 = cvtpk(P[BASE + 6], P[BASE + 7]);                              \
    auto r0 = __builtin_amdgcn_permlane32_swap(a0, b0, false, false); auto r1 = __builtin_amdgcn_permlane32_swap(a1, b1, false, false); \
    u32x4 w = {r0[0], r1[0], r0[1], r1[1]}; OUT = *reinterpret_cast<bf16x8*>(&w); } while (0)
  PK4(p0, 0, pa0); PK4(p0, 8, pa1); PK4(p1, 0, pa2); PK4(p1, 8, pa3);
#undef PK4
}
template <bool MLA> __device__ __forceinline__ void qkt(f32x16& p0, f32x16& p1, const char* Ks, const char* Krs, const bf16x8* qr, const char* qrl, int r32, int hi) {
  p0 = f32x16{}; p1 = f32x16{};
#pragma unroll
  for (int d0 = 0; d0 < 8; ++d0) { int cb = (d0 * 16 + hi * 8) * 2;
    bf16x8 b0 = *reinterpret_cast<const bf16x8*>(Ks + KSWZ(r32, cb));
    bf16x8 b1 = *reinterpret_cast<const bf16x8*>(Ks + KSWZ(32 + r32, cb));
    p0 = __builtin_amdgcn_mfma_f32_32x32x16_bf16(b0, qr[d0], p0, 0, 0, 0);
    p1 = __builtin_amdgcn_mfma_f32_32x32x16_bf16(b1, qr[d0], p1, 0, 0, 0); }
  if constexpr (MLA) {
#pragma unroll
    for (int d0 = 0; d0 < 4; ++d0) { int cb = (d0 * 16 + hi * 8) * 2;
      bf16x8 b0 = *reinterpret_cast<const bf16x8*>(Krs + KRSWZ(r32, cb));
      bf16x8 b1 = *reinterpret_cast<const bf16x8*>(Krs + KRSWZ(32 + r32, cb));
      const bf16x8 qf = *reinterpret_cast<const bf16x8*>(qrl + d0 * 1024);
      p0 = __builtin_amdgcn_mfma_f32_32x32x16_bf16(b0, qf, p0, 0, 0, 0);
      p1 = __builtin_amdgcn_mfma_f32_32x32x16_bf16(b1, qf, p1, 0, 0, 0); }
  }
}
__device__ __forceinline__ int v_st(int k, int c) { const int kk = (k & ~0xC) | ((k & 4) << 1) | ((k & 8) >> 1); return ((kk >> 3) * 4 + (c >> 5)) * 512 + ((kk & 7) * 32 + (c & 31)) * 2; }
__device__ __forceinline__ int v_rd_base(int lane) { return ((lane & 3) << 3) | (((lane >> 2) & 3) << 6) | (((lane >> 4) & 1) << 5) | (((lane >> 5) & 1) << 8); }
constexpr int v_rd_off(int d0, int ks, int half) { return d0 * 512 + ks * 4096 + half * 2048; }
template <int OFF> __device__ __forceinline__ s16x4 tr_read(int vb) {
  s16x4 r; asm volatile("ds_read_b64_tr_b16 %0, %1 offset:%2" : "=&v"(r) : "v"(vb), "i"(OFF) : "memory"); return r;
}
template <int D0> __device__ __forceinline__ void pv_one(f32x16& od, int vb, bf16x8 pa0, bf16x8 pa1, bf16x8 pa2, bf16x8 pa3) {
  s16x4 l0 = tr_read<v_rd_off(D0, 0, 0)>(vb), h0 = tr_read<v_rd_off(D0, 0, 1)>(vb), l1 = tr_read<v_rd_off(D0, 1, 0)>(vb), h1 = tr_read<v_rd_off(D0, 1, 1)>(vb);
  s16x4 l2 = tr_read<v_rd_off(D0, 2, 0)>(vb), h2 = tr_read<v_rd_off(D0, 2, 1)>(vb), l3 = tr_read<v_rd_off(D0, 3, 0)>(vb), h3 = tr_read<v_rd_off(D0, 3, 1)>(vb);
#define PK(L, H) (bf16x8){L[0], L[1], L[2], L[3], H[0], H[1], H[2], H[3]}
  asm volatile("s_waitcnt lgkmcnt(6)" : "+v"(l0), "+v"(h0) :: "memory"); SBAR();
  od = __builtin_amdgcn_mfma_f32_32x32x16_bf16(pa0, PK(l0, h0), od, 0, 0, 0);
  asm volatile("s_waitcnt lgkmcnt(4)" : "+v"(l1), "+v"(h1) :: "memory"); SBAR();
  od = __builtin_amdgcn_mfma_f32_32x32x16_bf16(pa1, PK(l1, h1), od, 0, 0, 0);
  asm volatile("s_waitcnt lgkmcnt(2)" : "+v"(l2), "+v"(h2) :: "memory"); SBAR();
  od = __builtin_amdgcn_mfma_f32_32x32x16_bf16(pa2, PK(l2, h2), od, 0, 0, 0);
  asm volatile("s_waitcnt lgkmcnt(0)" : "+v"(l3), "+v"(h3) :: "memory"); SBAR();
  od = __builtin_amdgcn_mfma_f32_32x32x16_bf16(pa3, PK(l3, h3), od, 0, 0, 0);
#undef PK
}
__device__ __forceinline__ void pv_d0(f32x16* o, int vb, bf16x8 pa0, bf16x8 pa1, bf16x8 pa2, bf16x8 pa3) {
  pv_one<0>(o[0], vb, pa0, pa1, pa2, pa3); pv_one<1>(o[1], vb, pa0, pa1, pa2, pa3); pv_one<2>(o[2], vb, pa0, pa1, pa2, pa3); pv_one<3>(o[3], vb, pa0, pa1, pa2, pa3);
}

template <bool MLA, int LDQ, int LDK, int LDSG, int LDY>
__device__ __forceinline__ void attn_body(const bf16* __restrict__ Qb, const bf16* __restrict__ Kh, const bf16* __restrict__ Vh, const bf16* __restrict__ Krh,
                                          const float* __restrict__ cosb, const float* __restrict__ sinb, const bf16* __restrict__ SGb, bf16* __restrict__ Yb, int seq, char* lds) {
  int tid_l = threadIdx.x; asm volatile("" : "+v"(tid_l));
  const int tid = tid_l, wid = __builtin_amdgcn_readfirstlane(tid >> 6), lane = tid & 63, r32 = lane & 31, hi = lane >> 5;
  char* V_lds = lds + OFF_V; char* K_lds = lds + OFF_K; char* KR_lds = lds + OFF_KR;
  float* ws = (float*)(lds + OFF_WS) + wid * 64; float* li_l = ws; float* al_l = ws + 32;
  float m_reg = -1e30f, l_reg = 0; f32x16 o[4] = {}; bf16x8 qr[8]; char* qrl = lds + OFF_QR + wid * 4096 + lane * 16;
  const bf16* Qw = Qb + (long)(wid * QBLK + r32) * LDQ + hi * 8;
#pragma unroll
  for (int d0 = 0; d0 < 8; ++d0) qr[d0] = *reinterpret_cast<const bf16x8*>(Qw + d0 * 16);
  if constexpr (MLA) {
    const float* cw = cosb + (wid * QBLK + r32) * 32 + hi * 8; const float* sw = sinb + (wid * QBLK + r32) * 32 + hi * 8;
#pragma unroll
    for (int dp = 0; dp < 2; ++dp) {
      const bf16x8 a = *reinterpret_cast<const bf16x8*>(Qw + 128 + dp * 16), b = *reinterpret_cast<const bf16x8*>(Qw + 160 + dp * 16);
      const f32x4 c0 = *reinterpret_cast<const f32x4*>(cw + dp * 16), c1 = *reinterpret_cast<const f32x4*>(cw + dp * 16 + 4);
      const f32x4 s0 = *reinterpret_cast<const f32x4*>(sw + dp * 16), s1 = *reinterpret_cast<const f32x4*>(sw + dp * 16 + 4);
      float o1[8], o2[8];
#pragma unroll
      for (int e = 0; e < 8; ++e) { const float x1 = bf2f(a[e]), x2 = bf2f(b[e]); const float c = e < 4 ? c0[e & 3] : c1[e & 3], s = e < 4 ? s0[e & 3] : s1[e & 3];
        o1[e] = x1 * c - x2 * s; o2[e] = x2 * c + x1 * s; }
      u32x4 w1 = {cvtpk(o1[0], o1[1]), cvtpk(o1[2], o1[3]), cvtpk(o1[4], o1[5]), cvtpk(o1[6], o1[7])};
      u32x4 w2 = {cvtpk(o2[0], o2[1]), cvtpk(o2[2], o2[3]), cvtpk(o2[4], o2[5]), cvtpk(o2[6], o2[7])};
      *reinterpret_cast<u32x4*>(qrl + dp * 1024) = w1; *reinterpret_cast<u32x4*>(qrl + (2 + dp) * 1024) = w2;
    }
  }
  const int vb0 = (int)(uintptr_t)V_lds + v_rd_base(lane);
  typedef __attribute__((address_space(3))) unsigned lds_u32;
  const unsigned lds0 = (unsigned)(uintptr_t)lds;
  const bf16* srcK[2]; const bf16* srcV[2]; const bf16* srcR = nullptr;
#pragma unroll
  for (int q = 0; q < 2; ++q) { const int pc = 2 * wid + q;
    { const int row = 4 * pc + (lane >> 4), lc = (lane & 15) ^ (row & 15); srcK[q] = Kh + (long)row * LDK + lc * 8; }
    { const int s = 2 * pc + (lane >> 5), kk = ((s >> 2) << 3) | ((lane & 31) >> 2), k = (kk & ~0xC) | ((kk & 4) << 1) | ((kk & 8) >> 1), c = (s & 3) * 32 + (lane & 3) * 8; srcV[q] = Vh + (long)k * LDK + c; } }
  if constexpr (MLA) { const int row = 8 * wid + (lane >> 3), lc = (lane & 7) ^ ((row >> 1) & 7); srcR = Krh + (long)row * 64 + lc * 8; }
#define GLDS(src, off) __builtin_amdgcn_global_load_lds((const unsigned*)(src), (lds_u32*)(uintptr_t)(unsigned)__builtin_amdgcn_readfirstlane((int)(lds0 + (off))), 16, 0, 0)
#define DMA(t, kb, vbuf) do { const long ko_ = (long)(t) * KVBLK * LDK; \
    GLDS(srcK[0] + ko_, OFF_K + (kb) * SHM_K + (2 * wid) * 1024); GLDS(srcK[1] + ko_, OFF_K + (kb) * SHM_K + (2 * wid + 1) * 1024); \
    GLDS(srcV[0] + ko_, OFF_V + (vbuf) * SHM_V + (2 * wid) * 1024); GLDS(srcV[1] + ko_, OFF_V + (vbuf) * SHM_V + (2 * wid + 1) * 1024); \
    if constexpr (MLA) GLDS(srcR + (long)(t) * KVBLK * 64, OFF_KR + (kb) * SHM_KR + wid * 1024); } while (0)
#define RESC(a) do { if (__any((a) < 1.f)) { if (hi == 0) al_l[r32] = (a); asm volatile("s_waitcnt lgkmcnt(0)" ::: "memory"); \
    for (int d = 0; d < 4; ++d) for (int r = 0; r < 16; ++r) o[d][r] *= al_l[crow(r, hi)]; } } while (0)
  f32x16 pA0, pA1, pB0, pB1; float mnA, mnB, alA, alB; bf16x8 pa0, pa1, pa2, pa3; const int NT = seq / KVBLK;
#define WBAR() asm volatile("s_waitcnt vmcnt(0) lgkmcnt(0)\n\ts_barrier" ::: "memory")
  DMA(0, 0, 0); DMA(1, 1, 1); WBAR();
  qkt<MLA>(pA0, pA1, K_lds, KR_lds, qr, qrl, r32, hi); partialSM<MLA>(pA0, pA1, m_reg, mnA, alA);
  WBAR();
  int vprev = 0, vnext = 2;
#define STEP(C0, C1, mnC, alC, Q0, Q1, alQ, j, KB) do { \
    if ((j) + 1 < NT) DMA((j) + 1, (KB) ^ 1, vnext); \
    SBAR(); qkt<MLA>(C0, C1, K_lds + (KB) * SHM_K, KR_lds + (KB) * SHM_KR, qr, qrl, r32, hi); \
    finishSM(Q0, Q1, alQ, l_reg, pa0, pa1, pa2, pa3); SBAR(); \
    pv_d0(o, vb0 + vprev * (int)SHM_V, pa0, pa1, pa2, pa3); partialSM<MLA>(C0, C1, m_reg, mnC, alC); \
    RESC(alC); \
    WBAR(); \
    vprev = (vprev == NVBUF - 1) ? 0 : vprev + 1; vnext = (vnext == NVBUF - 1) ? 0 : vnext + 1; } while (0)
  for (int j = 1; j + 1 < NT; j += 2) { STEP(pB0, pB1, mnB, alB, pA0, pA1, alA, j, 1); STEP(pA0, pA1, mnA, alA, pB0, pB1, alB, j + 1, 0); }
  STEP(pB0, pB1, mnB, alB, pA0, pA1, alA, NT - 1, 1);
#undef STEP
  finishSM(pB0, pB1, alB, l_reg, pa0, pa1, pa2, pa3); SBAR();
  pv_d0(o, vb0 + vprev * (int)SHM_V, pa0, pa1, pa2, pa3);
  WBAR();
#undef WBAR
#undef DMA
#undef GLDS
  if (hi == 0) li_l[r32] = l_reg; asm volatile("s_waitcnt lgkmcnt(0)" ::: "memory");
  float rli[16];
#pragma unroll
  for (int r = 0; r < 16; ++r) rli[r] = __builtin_amdgcn_rcpf(li_l[crow(r, hi)]);
  int lo_ = lane; asm volatile("" : "+v"(lo_));
  char* stg = lds + (wid < 2 ? wid * 8192 : OFF_K + (wid - 2) * 8192);
  { const int r32o = lo_ & 31, hio = lo_ >> 5;
#pragma unroll
    for (int r = 0; r < 16; ++r) { const int orow = (r & 3) + 8 * (r >> 2) + 4 * hio;
#pragma unroll
      for (int d0 = 0; d0 < 4; d0 += 2) { const unsigned w = cvtpk(o[d0][r] * rli[r], o[d0 + 1][r] * rli[r]);
        *(bf16*)(stg + orow * 256 + (d0 * 32 + r32o) * 2) = (bf16)(w & 0xffffu); *(bf16*)(stg + orow * 256 + ((d0 + 1) * 32 + r32o) * 2) = (bf16)(w >> 16); } } }
  asm volatile("s_waitcnt lgkmcnt(0)" ::: "memory");
  { const int rw = lo_ >> 4, ch = lo_ & 15;
    const bf16* SGw = SGb + (long)(wid * QBLK + rw) * LDSG + ch * 8; bf16* Yw = Yb + (long)(wid * QBLK + rw) * LDY + ch * 8;
#pragma unroll
    for (int i = 0; i < 8; ++i) { const u32x4 v = *(const u32x4*)(stg + (i * 4 + rw) * 256 + ch * 16); const u32x4 g = *(const u32x4*)(SGw + (long)(i * 4) * LDSG);
      u32x4 w;
#define MULPK(a, b) cvtpk(__uint_as_float((a) << 16) * __uint_as_float((b) << 16), __uint_as_float((a) & 0xffff0000u) * __uint_as_float((b) & 0xffff0000u))
      w.x = MULPK(v.x, g.x); w.y = MULPK(v.y, g.y); w.z = MULPK(v.z, g.z); w.w = MULPK(v.w, g.w);
#undef MULPK
      *(u32x4*)(Yw + (long)(i * 4) * LDY) = w; } }
  __syncthreads();
#undef RESC
}
#undef SBAR
}
#define LAS __attribute__((address_space(3)))
typedef unsigned short bf16;
typedef float f32x4 __attribute__((ext_vector_type(4)));
typedef unsigned u32x4 __attribute__((ext_vector_type(4)));
typedef unsigned u32x2 __attribute__((ext_vector_type(2)));
constexpr int BATCH = 8, SEQ = 4096, DM = 2048, DEPTH = 4, T = BATCH * SEQ, MEMT = 256, MROWS = BATCH * MEMT;
constexpr int INC = 4928, ZC = 5120;
constexpr int ZO_QLAT = 0, ZO_KVLAT = 512, ZO_KPE = 768, ZO_GB = 1024, ZO_GC = 1536, ZO_XIN = 2048, ZO_QMEM = 2560, ZO_GATE = 3072;
constexpr int QC = 1536, KVC = 2048, MKVC = 4096;
constexpr float EPS = 1e-6f;
constexpr size_t MiB = 1u << 20;
constexpr size_t WS_WIN = 2 * MiB, WS_WUQ = 82 * MiB, WS_WUKV = 88 * MiB, WS_WM = 92 * MiB, WS_WO = 108 * MiB, WS_MEMH = 140 * MiB, WS_MKV = 148 * MiB,
                 WS_COS = 164 * MiB, WS_SIN = 168 * MiB, WS_SSQ = 172 * MiB, WS_KPE = 174 * MiB, WS_HQ = 180 * MiB, WS_KV = 308 * MiB, WS_Y = 436 * MiB, WS_ZO = 564 * MiB, WS_Q = 884 * MiB, WS_END = 980 * MiB;
constexpr size_t WS_SSQX = WS_SSQ + (size_t)T * 12 * 4;
constexpr int LDS_MAIN = 8 * 64 * 65 * 4;
constexpr int LDS_BYTES = LDS_MAIN + 256;
constexpr size_t CTL_BYTES = 16384;
#ifndef MK_DUP
#define MK_DUP -1
#endif
constexpr int NPRO = (MK_DUP == 5) ? 2 : 1, SLOTS = 5 + ((MK_DUP >= 0 && MK_DUP != 5) ? 1 : 0);
constexpr int NPHASE = NPRO + SLOTS * DEPTH;

#ifndef MK_DUP
#define MK_DUP -1
#endif
#ifndef MK_EN
#define MK_EN 0xff
#endif
#define EN(k) ((MK_EN >> (k)) & 1)
struct Params {
    const float *x, *mem; const int* pos; const float *pre_g, *w_in, *qn_g, *w_uq, *kvn_g, *w_ukv, *conv_w, *memn_g, *w_mk, *w_mv, *w_o, *post_g;
    float* out; unsigned char* ws; float inv_freq[32]; int ph_lo, ph_hi;
};

__device__ __forceinline__ unsigned f2bf(float f) { unsigned u = __builtin_bit_cast(unsigned, f); return (u + 0x7fffu + ((u >> 16) & 1u)) >> 16; }
__device__ __forceinline__ unsigned pk2(float lo, float hi) { return f2bf(lo) | (f2bf(hi) << 16); }
__device__ __forceinline__ float bfl(unsigned w) { return __uint_as_float(w << 16); }
__device__ __forceinline__ float bfh(unsigned w) { return __uint_as_float(w & 0xffff0000u); }
__device__ __forceinline__ float wave_sum(float v) {
#pragma unroll
    for (int o = 1; o < 64; o <<= 1) v += __shfl_xor(v, o);
    return v;
}
constexpr int TR_LDS = 64 * 65 * 4;
__device__ __forceinline__ void transpose_item(const float* W, const float* g, int K, int N, bf16* WT, int row_off, int pad_from, int pad_add, LAS float* scr, int item, int lane) {
    const int nblk = N / 64, kb = item / nblk, nb = item % nblk, k0 = 64 * kb, n0 = 64 * nb;
    const int lr = lane >> 4, lc = (lane & 15) * 4;
    f32x4 v[16];
#pragma unroll
    for (int i = 0; i < 16; ++i) v[i] = __builtin_nontemporal_load((const f32x4*)(W + (size_t)(k0 + 4 * i + lr) * N + n0 + lc));
#pragma unroll
    for (int i = 0; i < 16; ++i) { const int kk = 4 * i + lr; f32x4 x = v[i]; if (g) x = x * g[k0 + kk];
        LAS float* d = scr + kk * 65 + lc; d[0] = x.x; d[1] = x.y; d[2] = x.z; d[3] = x.w; }
    asm volatile("s_waitcnt lgkmcnt(0)" ::: "memory");
    const int c = lane & 7; const int drow0 = row_off + n0 + (n0 >= pad_from ? pad_add : 0);
#pragma unroll
    for (int j = 0; j < 8; ++j) { const int n = (lane >> 3) + 8 * j; const LAS float* s = scr + (8 * c) * 65 + n;
        u32x4 o; o.x = pk2(s[0 * 65], s[1 * 65]); o.y = pk2(s[2 * 65], s[3 * 65]); o.z = pk2(s[4 * 65], s[5 * 65]); o.w = pk2(s[6 * 65], s[7 * 65]);
        *(u32x4*)(WT + (size_t)(drow0 + n) * K + k0 + 8 * c) = o; }
    asm volatile("s_waitcnt lgkmcnt(0)" ::: "memory");
}
__device__ __forceinline__ void prenorm_row(const float* xr, const float* g, bf16* hr, int lane) {
    f32x4 v[8]; float s = 0.f;
#pragma unroll
    for (int j = 0; j < 4; ++j) { v[2 * j] = *(const f32x4*)(xr + j * 512 + lane * 8); v[2 * j + 1] = *(const f32x4*)(xr + j * 512 + lane * 8 + 4); }
#pragma unroll
    for (int j = 0; j < 8; ++j) s += (v[j].x * v[j].x + v[j].y * v[j].y) + (v[j].z * v[j].z + v[j].w * v[j].w);
    const float rstd = 1.0f / sqrtf(wave_sum(s) * (1.0f / DM) + EPS);
#pragma unroll
    for (int j = 0; j < 4; ++j) { f32x4 a = v[2 * j] * rstd, b = v[2 * j + 1] * rstd;
        if (g) { a = a * *(const f32x4*)(g + j * 512 + lane * 8); b = b * *(const f32x4*)(g + j * 512 + lane * 8 + 4); }
        u32x4 w; w.x = pk2(a.x, a.y); w.y = pk2(a.z, a.w); w.z = pk2(b.x, b.y); w.w = pk2(b.z, b.w);
        *(u32x4*)(hr + j * 512 + lane * 8) = w; }
}
__device__ __forceinline__ void cvt_row(const float* xr, bf16* hr, float* ssq, int lane) {
    f32x4 v[8]; float s = 0.f;
#pragma unroll
    for (int j = 0; j < 4; ++j) { v[2 * j] = __builtin_nontemporal_load((const f32x4*)(xr + j * 512 + lane * 8)); v[2 * j + 1] = __builtin_nontemporal_load((const f32x4*)(xr + j * 512 + lane * 8 + 4)); }
#pragma unroll
    for (int j = 0; j < 8; ++j) s += (v[j].x * v[j].x + v[j].y * v[j].y) + (v[j].z * v[j].z + v[j].w * v[j].w);
    s = wave_sum(s);
#pragma unroll
    for (int j = 0; j < 4; ++j) { const f32x4 a = v[2 * j], b = v[2 * j + 1];
        u32x4 w; w.x = pk2(a.x, a.y); w.y = pk2(a.z, a.w); w.z = pk2(b.x, b.y); w.w = pk2(b.z, b.w);
        *(u32x4*)(hr + j * 512 + lane * 8) = w; }
    if (lane == 0) *ssq = s;
}
struct RowIn { u32x4 x[4]; u32x4 w[4]; };
__device__ __forceinline__ void post_load(RowIn& R, const bf16* xr, const bf16* orow, int lane) {
#pragma unroll
    for (int j = 0; j < 4; ++j) { R.x[j] = *(const u32x4*)(xr + j * 512 + lane * 8); R.w[j] = __builtin_nontemporal_load((const u32x4*)(orow + j * 512 + lane * 8)); }
}
__device__ __forceinline__ void post_finish(RowIn& R, const float* gpost, bool last, float* outr, bf16* xw, float* ssq, int lane) {
    f32x4 ov[8], v[8]; float s = 0.f;
#pragma unroll
    for (int j = 0; j < 4; ++j) { const u32x4 w = R.w[j], x = R.x[j];
        ov[2 * j] = (f32x4){bfl(w.x), bfh(w.x), bfl(w.y), bfh(w.y)}; ov[2 * j + 1] = (f32x4){bfl(w.z), bfh(w.z), bfl(w.w), bfh(w.w)};
        v[2 * j] = (f32x4){bfl(x.x), bfh(x.x), bfl(x.y), bfh(x.y)}; v[2 * j + 1] = (f32x4){bfl(x.z), bfh(x.z), bfl(x.w), bfh(x.w)}; }
#pragma unroll
    for (int j = 0; j < 8; ++j) s += (ov[j].x * ov[j].x + ov[j].y * ov[j].y) + (ov[j].z * ov[j].z + ov[j].w * ov[j].w);
    const float rso = 1.0f / sqrtf(wave_sum(s) * (1.0f / DM) + EPS);
#pragma unroll
    for (int j = 0; j < 4; ++j) {
        v[2 * j] = v[2 * j] + ov[2 * j] * rso * *(const f32x4*)(gpost + j * 512 + lane * 8);
        v[2 * j + 1] = v[2 * j + 1] + ov[2 * j + 1] * rso * *(const f32x4*)(gpost + j * 512 + lane * 8 + 4); }
    if (last) {
#pragma unroll
        for (int j = 0; j < 4; ++j) { __builtin_nontemporal_store(v[2 * j], (f32x4*)(outr + j * 512 + lane * 8)); __builtin_nontemporal_store(v[2 * j + 1], (f32x4*)(outr + j * 512 + lane * 8 + 4)); }
    } else {
        float s2 = 0.f;
#pragma unroll
        for (int j = 0; j < 8; ++j) s2 += (v[j].x * v[j].x + v[j].y * v[j].y) + (v[j].z * v[j].z + v[j].w * v[j].w);
        s2 = wave_sum(s2);
#pragma unroll
        for (int j = 0; j < 4; ++j) { const f32x4 a = v[2 * j], b = v[2 * j + 1];
            u32x4 w; w.x = pk2(a.x, a.y); w.y = pk2(a.z, a.w); w.z = pk2(b.x, b.y); w.w = pk2(b.z, b.w);
            *(u32x4*)(xw + j * 512 + lane * 8) = w; }
        if (lane == 0) *ssq = s2;
    }
}
__device__ __forceinline__ void sincos_acc(float a, float& s, float& c) {
    const double x = (double)a; const double k = __builtin_rint(x * 0.63661977236758134308);
    const float r = (float)__builtin_fma(-k, 1.57079632679489661923, x), r2 = r * r;
    const float sp = r * (1.0f + r2 * (-1.6666667163e-1f + r2 * (8.3333337680e-3f + r2 * (-1.9841270114e-4f + r2 * 2.7557314297e-6f))));
    const float cp = 1.0f + r2 * (-0.5f + r2 * (4.1666667908e-2f + r2 * (-1.3888889225e-3f + r2 * (2.4801587642e-5f + r2 * -2.7557314297e-7f))));
    const int q = ((int)k) & 3;
    s = (q == 0) ? sp : (q == 1) ? cp : (q == 2) ? -sp : -cp;
    c = (q == 0) ? cp : (q == 1) ? -sp : (q == 2) ? -cp : sp;
}
__device__ __forceinline__ void unpack8(const u32x4 w, float* f) { f[0] = bfl(w.x); f[1] = bfh(w.x); f[2] = bfl(w.y); f[3] = bfh(w.y); f[4] = bfl(w.z); f[5] = bfh(w.z); f[6] = bfl(w.w); f[7] = bfh(w.w); }

#define RLX_AGENT __ATOMIC_RELAXED, __HIP_MEMORY_SCOPE_AGENT
#define XB_TMO      128
#define XB_XCNT(j)  (256  + 64 * (j))
#define XB_XSUB(j)  (1280 + 64 * (j))
#define XB_XGEN(j)  (2304 + 64 * (j))
#define XB_TOP      3328
#define XB_TOPGEN   3392
#define XCD_BAR_WORDS 3456
#define XB_SPIN_CAP (1u << 18)

__device__ __forceinline__ unsigned xb_ld(unsigned* p)              { return __hip_atomic_load(p, __ATOMIC_RELAXED, __HIP_MEMORY_SCOPE_AGENT); }
__device__ __forceinline__ unsigned xb_add(unsigned* p, unsigned v) { return __hip_atomic_fetch_add(p, v, __ATOMIC_RELAXED, __HIP_MEMORY_SCOPE_AGENT); }
__device__ __forceinline__ unsigned xb_xcc_id() { return (unsigned)__builtin_amdgcn_s_getreg((3 << 11) | 20) & 0xFu; }
#define XB_SPIN(cond, bar) do { unsigned _sp = 0; while (cond) { __builtin_amdgcn_s_sleep(1); \
    if ((++_sp & 255u) == 0u) { if (xb_ld(&(bar)[XB_TMO])) break; if (_sp > XB_SPIN_CAP) { atomicAdd(&(bar)[XB_TMO], 1u); break; } } } } while (0)

struct XcdBarrier {
    unsigned* bar; unsigned x;
    volatile LAS unsigned* st;
};

__device__ __forceinline__ XcdBarrier xcd_barrier_post(unsigned* bar, volatile LAS unsigned* st) {
    XcdBarrier b; b.bar = bar; b.x = xb_xcc_id(); b.st = st;
    if (threadIdx.x == 0) (void)xb_add(&bar[XB_XCNT(b.x)], 1u);
    return b;
}
__device__ __forceinline__ void xcd_barrier_complete(unsigned* bar, unsigned x, unsigned& nloc, unsigned& nx) {
    const unsigned G = gridDim.x * gridDim.y * gridDim.z;
    unsigned sum, cnt, mine, sp = 0u;
    for (;;) {
        sum = 0u; cnt = 0u; mine = 0u;
#pragma unroll
        for (unsigned j = 0; j < 16; ++j) { const unsigned c = xb_ld(&bar[XB_XCNT(j)]); sum += c; cnt += (c > 0u) ? 1u : 0u; mine = (j == x) ? c : mine; }
        if (sum == G) break;
        __builtin_amdgcn_s_sleep(1);
        if ((++sp & 255u) == 0u) { if (xb_ld(&bar[XB_TMO])) break; if (sp > XB_SPIN_CAP) { atomicAdd(&bar[XB_TMO], 1u); break; } }
    }
    nloc = mine > 0u ? mine : 1u; nx = cnt > 0u ? cnt : 1u;
}

__device__ __forceinline__ void xcd_barrier(const XcdBarrier& b) {
    asm volatile("s_waitcnt vmcnt(0)" ::: "memory");
    __syncthreads();
    if (threadIdx.x == 0) {
        unsigned* bar = b.bar;
        __builtin_amdgcn_s_waitcnt(0);
        unsigned nloc = b.st[0], nx = b.st[1];
        if (nloc == 0u) { xcd_barrier_complete(bar, b.x, nloc, nx); b.st[0] = nloc; b.st[1] = nx; }
        const unsigned old = xb_add(&bar[XB_XSUB(b.x)], 1u);
        const unsigned gen = old / nloc;
        if (old + 1u == (gen + 1u) * nloc) {
            __builtin_amdgcn_fence(__ATOMIC_RELEASE, "agent");
            asm volatile("s_waitcnt vmcnt(0)" ::: "memory");
            const unsigned og = xb_add(&bar[XB_TOP], 1u);
            const unsigned tg = og / nx;
            if (og + 1u == (tg + 1u) * nx) xb_add(&bar[XB_TOPGEN], 1u);
            else XB_SPIN(xb_ld(&bar[XB_TOPGEN]) == tg, bar);
            __builtin_amdgcn_fence(__ATOMIC_ACQUIRE, "agent");
            xb_add(&bar[XB_XGEN(b.x)], 1u);
            asm volatile("s_waitcnt vmcnt(0)" ::: "memory");
        } else {
            XB_SPIN(xb_ld(&bar[XB_XGEN(b.x)]) == gen, bar);
            __builtin_amdgcn_fence(__ATOMIC_ACQUIRE, "agent");
            asm volatile("s_waitcnt vmcnt(0)" ::: "memory");
        }
    }
    __syncthreads();
}

#define WIN ((bf16*)(ws + WS_WIN))
#define WUQ ((bf16*)(ws + WS_WUQ))
#define WUKV ((bf16*)(ws + WS_WUKV))
#define WM ((bf16*)(ws + WS_WM))
#define WO ((bf16*)(ws + WS_WO))
#define MEMH ((bf16*)(ws + WS_MEMH))
#define MKV ((bf16*)(ws + WS_MKV))
#define COS ((float*)(ws + WS_COS))
#define SIN ((float*)(ws + WS_SIN))
#define SSQ ((float*)(ws + WS_SSQ))
#define SSQX ((float*)(ws + WS_SSQX))
#define KPE ((bf16*)(ws + WS_KPE))
#define H ((bf16*)(ws + WS_HQ))
#define Q ((bf16*)(ws + WS_Q))
#define KV ((bf16*)(ws + WS_KV))
#define Y ((bf16*)(ws + WS_Y))
#define Z ((bf16*)(ws + WS_ZO))
#define O ((bf16*)(ws + WS_ZO))
__global__ void __launch_bounds__(512, 2) fwd_megakernel(Params P_) {
    extern __shared__ __attribute__((aligned(16))) unsigned char lds[];
    cg::grid_group grid = cg::this_grid();
    const int G = gridDim.x, bid = blockIdx.x;

    const int ph_lo = P_.ph_lo, ph_hi = P_.ph_hi;
    volatile LAS unsigned* bst = (volatile LAS unsigned*)((LAS unsigned char*)lds + LDS_MAIN);
    if (threadIdx.x < 2) bst[threadIdx.x] = 0u;
    __syncthreads();
    const XcdBarrier xbar = xcd_barrier_post((unsigned*)P_.ws, bst);
    for (int p = ph_lo; p < ph_hi; ++p) {
        int tid_l = threadIdx.x; asm volatile("" : "+v"(tid_l));
        const int tid = tid_l, lane = tid & 63, wave = __builtin_amdgcn_readfirstlane(tid >> 6);
        const int gw = bid * 8 + wave, NGW = G * 8; const int gt = bid * 512 + tid, NGT = G * 512;
        const __attribute__((address_space(4))) Params* Pp = (const __attribute__((address_space(4))) Params*)__builtin_amdgcn_kernarg_segment_ptr();
        asm volatile("" : "+s"(Pp));
#define P (*Pp)
        unsigned char* ws = P.ws;
    LAS unsigned char* ldsl = (LAS unsigned char*)lds;
        if (p < NPRO && EN(5)) {
            LAS float* scr = (LAS float*)(ldsl + wave * TR_LDS);
            constexpr int I_IN = 32 * 77, I_UQ = 8 * 24, I_UKV = 4 * 32, I_MK = 32 * 8, I_O = 32 * 32, I_L = I_IN + I_UQ + I_UKV + 2 * I_MK + I_O;
            for (int it = gw; it < DEPTH * I_L; it += NGW) {
                const int l = it / I_L; int r = it % I_L;
                if (r < I_IN) { transpose_item(P.w_in + (size_t)l * DM * INC, P.pre_g + l * DM, DM, INC, WIN + (size_t)l * ZC * DM, 0, 832, 192, scr, r, lane); continue; } r -= I_IN;
                if (r < I_UQ) { transpose_item(P.w_uq + (size_t)l * 512 * QC, P.qn_g + l * 512, 512, QC, WUQ + (size_t)l * QC * 512, 0, 1 << 30, 0, scr, r, lane); continue; } r -= I_UQ;
                if (r < I_UKV) { transpose_item(P.w_ukv + (size_t)l * 256 * KVC, P.kvn_g + l * 256, 256, KVC, WUKV + (size_t)l * KVC * 256, 0, 1 << 30, 0, scr, r, lane); continue; } r -= I_UKV;
                if (r < I_MK) { transpose_item(P.w_mk + (size_t)l * DM * 512, P.memn_g + l * DM, DM, 512, WM + (size_t)l * 1024 * DM, 0, 1 << 30, 0, scr, r, lane); continue; } r -= I_MK;
                if (r < I_MK) { transpose_item(P.w_mv + (size_t)l * DM * 512, P.memn_g + l * DM, DM, 512, WM + (size_t)l * 1024 * DM, 512, 1 << 30, 0, scr, r, lane); continue; } r -= I_MK;
                transpose_item(P.w_o + (size_t)l * DM * DM, nullptr, DM, DM, WO + (size_t)l * DM * DM, 0, 1 << 30, 0, scr, r, lane);
            }
            for (int i = gt; i < DEPTH * 192 * DM / 8; i += NGT) { const int l = i / (192 * DM / 8); const int j = i % (192 * DM / 8);
                *(u32x4*)(WIN + (size_t)l * ZC * DM + (size_t)832 * DM + (size_t)j * 8) = (u32x4){0u, 0u, 0u, 0u}; }
            for (int m = gw; m < T; m += NGW) cvt_row(P.x + (size_t)m * DM, H + (size_t)m * DM, SSQX + m, lane);
            for (int m = gw; m < MROWS; m += NGW) prenorm_row(P.mem + (size_t)m * DM, nullptr, MEMH + (size_t)m * DM, lane);
            for (int i = gt; i < T * 32; i += NGT) { const int row = i >> 5, j = i & 31;
                const float ang = (float)P.pos[row] * P.inv_freq[j]; float s, c; sincos_acc(ang, s, c); COS[i] = c; SIN[i] = s; }
        } else {
            const int l = (p - NPRO) / SLOTS, sk = (p - NPRO) % SLOTS, st = (MK_DUP == 6) ? sk : (MK_DUP >= 0 && sk > MK_DUP) ? sk - 1 : sk;
            if (st == 0 && EN(0)) {
                if (l == 0) { pg8::Gemm g{MEMH, WM, MROWS, MKVC, DM, DM}; pg8::StaticOrder S; S.init(MROWS, MKVC, G, bid);
                    pg8::EpiRow E{MKV, MKVC, nullptr, 0, 0, 0.f}; pg8::gemm_phase<pg8::EpiRow, pg8::StaticOrder, true, true>(ldsl, g, S, E); }
                pg8::Gemm g{H, WIN + (size_t)l * ZC * DM, T, ZC, DM, DM}; pg8::StaticOrder S; S.init(T, ZC, G, bid);
                pg8::EpiZ E{Z, SSQ, SSQX, ZC, ZO_GATE / 256, 3}; pg8::gemm_phase<pg8::EpiZ, pg8::StaticOrder, true, true>(ldsl, g, S, E);
            } else if (st == 1 && EN(1)) {
                for (int i = gt; i < T * 8; i += NGT) { const int row = i >> 3, j = i & 7;
                    const u32x2 a = *(const u32x2*)(Z + (size_t)row * ZC + ZO_KPE + j * 4), b = *(const u32x2*)(Z + (size_t)row * ZC + ZO_KPE + 32 + j * 4);
                    const f32x4 c = *(const f32x4*)(COS + (size_t)row * 32 + j * 4), s = *(const f32x4*)(SIN + (size_t)row * 32 + j * 4);
                    const float x1[4] = {bfl(a.x), bfh(a.x), bfl(a.y), bfh(a.y)}, x2[4] = {bfl(b.x), bfh(b.x), bfl(b.y), bfh(b.y)};
                    float o1[4], o2[4];
#pragma unroll
                    for (int e = 0; e < 4; ++e) { o1[e] = x1[e] * c[e] - x2[e] * s[e]; o2[e] = x2[e] * c[e] + x1[e] * s[e]; }
                    *(u32x2*)(KPE + (size_t)row * 64 + j * 4) = (u32x2){pk2(o1[0], o1[1]), pk2(o1[2], o1[3])};
                    *(u32x2*)(KPE + (size_t)row * 64 + 32 + j * 4) = (u32x2){pk2(o2[0], o2[1]), pk2(o2[2], o2[3])}; }
                const float* cw = P.conv_w + (size_t)l * 3 * 512;
                for (int i = gt; i < (T / 4) * 64; i += NGT) { const int row0 = (i >> 6) * 4, c8 = (i & 63) * 8, sp0 = row0 & (SEQ - 1);
                    const bf16* zr = Z + (size_t)row0 * ZC;
                    const bool hb = sp0 > 0, ha = sp0 + 4 < SEQ;
                    u32x4 gcr[6], xir[6], gbr[4], sgr[4];
#pragma unroll
                    for (int r = 0; r < 6; ++r) { const int rr = (r == 0 && !hb) ? 0 : (r == 5 && !ha) ? 3 : r - 1;
                        gcr[r] = __builtin_nontemporal_load((const u32x4*)(zr + (long)rr * ZC + ZO_GC + c8)); xir[r] = __builtin_nontemporal_load((const u32x4*)(zr + (long)rr * ZC + ZO_XIN + c8)); }
#pragma unroll
                    for (int r = 0; r < 4; ++r) { gbr[r] = __builtin_nontemporal_load((const u32x4*)(zr + (long)r * ZC + ZO_GB + c8)); sgr[r] = __builtin_nontemporal_load((const u32x4*)(zr + (long)r * ZC + ZO_GATE + 1024 + c8)); }
                    float w0[8], w1[8], w2[8];
#pragma unroll
                    for (int e = 0; e < 8; ++e) { w0[e] = cw[c8 + e]; w1[e] = cw[512 + c8 + e]; w2[e] = cw[1024 + c8 + e]; }
                    float u[6][8];
#pragma unroll
                    for (int r = 0; r < 6; ++r) { float a[8], b[8]; unpack8(gcr[r], a); unpack8(xir[r], b); const float keep = ((r == 0 && !hb) || (r == 5 && !ha)) ? 0.f : 1.f;
#pragma unroll
                        for (int e = 0; e < 8; ++e) u[r][e] = a[e] * b[e] * keep; }
#pragma unroll
                    for (int r = 0; r < 4; ++r) { float gb[8], sg[8], o[8]; unpack8(gbr[r], gb); unpack8(sgr[r], sg);
#pragma unroll
                        for (int e = 0; e < 8; ++e) o[e] = gb[e] * (u[r][e] * w0[e] + u[r + 1][e] * w1[e] + u[r + 2][e] * w2[e]) * sg[e];
                        *(u32x4*)(Y + (size_t)(row0 + r) * DM + 1024 + c8) = (u32x4){pk2(o[0], o[1]), pk2(o[2], o[3]), pk2(o[4], o[5]), pk2(o[6], o[7])}; }
                }
                { pg8::Gemm g{Z + ZO_QLAT, WUQ + (size_t)l * QC * 512, T, QC, 512, ZC}; pg8::StaticOrder S; S.init(T, QC, G, bid);
                  pg8::EpiRow E{Q, QC, SSQ, 0, 8, 1.0f / 512}; pg8::gemm_phase<pg8::EpiRow, pg8::StaticOrder, true, false>(ldsl, g, S, E); }
                { pg8::Gemm g{Z + ZO_KVLAT, WUKV + (size_t)l * KVC * 256, T, KVC, 256, ZC}; pg8::StaticOrder S; S.init(T, KVC, G, bid);
                  pg8::EpiRow E{KV, KVC, SSQ, 8, 4, 1.0f / 256}; pg8::gemm_phase<pg8::EpiRow, pg8::StaticOrder, true, false>(ldsl, g, S, E); }
            } else if (st == 2 && EN(2)) {
                const int vcu = (G % 8 == 0) ? (bid % 8) * (G / 8) + bid / 8 : bid;
                for (int idx = vcu; idx < 1536; idx += G) {
                    if (idx < 1024 && EN(6)) { const int bh = idx >> 4, qb = idx & 15, b = bh >> 3, h = bh & 7; const size_t row0 = (size_t)b * SEQ + qb * 256, kr0 = (size_t)b * SEQ;
                        att::attn_body<true, QC, KVC, ZC, DM>(Q + row0 * QC + h * 192, KV + kr0 * KVC + h * 256, KV + kr0 * KVC + h * 256 + 128, KPE + kr0 * 64,
                            COS + row0 * 32, SIN + row0 * 32, Z + row0 * ZC + ZO_GATE + h * 128, Y + row0 * DM + h * 128, SEQ, (char*)lds);
                    } else if (EN(7)) { const int j = idx - 1024, bh = j >> 4, qb = j & 15, b = bh >> 2, h = bh & 3; const size_t row0 = (size_t)b * SEQ + qb * 256, kr0 = (size_t)b * MEMT;
                        att::attn_body<false, ZC, MKVC, ZC, DM>(Z + row0 * ZC + ZO_QMEM + h * 128, MKV + kr0 * MKVC + l * 1024 + h * 128, MKV + kr0 * MKVC + l * 1024 + 512 + h * 128, nullptr,
                            nullptr, nullptr, Z + row0 * ZC + ZO_GATE + 1536 + h * 128, Y + row0 * DM + 1536 + h * 128, MEMT, (char*)lds);
                    }
                }
            } else if (st == 3 && EN(3)) {
                pg8::Gemm g{Y, WO + (size_t)l * DM * DM, T, DM, DM, DM}; pg8::StaticOrder S; S.init(T, DM, G, bid);
                pg8::EpiRow E{O, DM, nullptr, 0, 0, 0.f}; pg8::gemm_phase<pg8::EpiRow, pg8::StaticOrder, true, true>(ldsl, g, S, E);
            } else if (EN(4)) {
                const float* gpost = P.post_g + l * DM; const bool last = (l + 1 == DEPTH); float* outp = P.out;
                for (int m = gw; m < T; m += 2 * NGW) { const int m2 = m + NGW, mc = m2 < T ? m2 : m; RowIn Ra, Rb;
                    post_load(Ra, H + (size_t)m * DM, O + (size_t)m * DM, lane);
                    post_load(Rb, H + (size_t)mc * DM, O + (size_t)mc * DM, lane);
                    post_finish(Ra, gpost, last, outp + (size_t)m * DM, H + (size_t)m * DM, SSQX + m, lane);
                    if (m2 < T) post_finish(Rb, gpost, last, outp + (size_t)m2 * DM, H + (size_t)m2 * DM, SSQX + m2, lane); }
            }
        }
        if (p + 1 < ph_hi) { if (p == ph_lo) grid.sync(); else xcd_barrier(xbar); }
#undef P
    }
}

#undef WIN
#undef WUQ
#undef WUKV
#undef WM
#undef WO
#undef MEMH
#undef MKV
#undef COS
#undef SIN
#undef SSQ
#undef SSQX
#undef KPE
#undef H
#undef Q
#undef KV
#undef Y
#undef Z
#undef O
#ifndef MK_MULTI
#define MK_MULTI 0
#endif
extern "C" void kernel_launch(void* const* d_in, const int* in_sizes, int n_in, void* d_out, int out_size, void* d_ws, size_t ws_size, hipStream_t stream) {
    static int grid = 0;
    if (grid == 0) {
        if (n_in != 15 || in_sizes[0] != T * DM || out_size != T * DM || ws_size < WS_END) { fprintf(stderr, "kernel_launch: unexpected shapes (n_in %d in0 %d out %d ws %zu)\n", n_in, n_in > 0 ? in_sizes[0] : -1, out_size, ws_size); grid = -1; return; }
        int dev = 0, cus = 0, per_cu = 0;
        hipGetDevice(&dev); hipDeviceGetAttribute(&cus, hipDeviceAttributeMultiprocessorCount, dev);
        if (hipFuncSetAttribute((const void*)fwd_megakernel, hipFuncAttributeMaxDynamicSharedMemorySize, LDS_BYTES) != hipSuccess) { fprintf(stderr, "kernel_launch: hipFuncSetAttribute failed\n"); grid = -1; return; }
        if (hipOccupancyMaxActiveBlocksPerMultiprocessor(&per_cu, (const void*)fwd_megakernel, 512, LDS_BYTES) != hipSuccess || per_cu < 1) { fprintf(stderr, "kernel_launch: occupancy query says %d\n", per_cu); per_cu = 1; }
        (void)hipGetLastError();
        grid = cus * 1;
        fprintf(stderr, "kernel_launch: grid %d (cus %d, per_cu %d), ws %zu\n", grid, cus, per_cu, ws_size);
    }
    if (grid < 0) return;
    if (hipMemsetAsync(d_ws, 0, CTL_BYTES, stream) != hipSuccess) { fprintf(stderr, "kernel_launch: memset failed\n"); return; }
    Params p{};
    p.x = (const float*)d_in[0]; p.mem = (const float*)d_in[1]; p.pos = (const int*)d_in[2]; p.pre_g = (const float*)d_in[3]; p.w_in = (const float*)d_in[4];
    p.qn_g = (const float*)d_in[5]; p.w_uq = (const float*)d_in[6]; p.kvn_g = (const float*)d_in[7]; p.w_ukv = (const float*)d_in[8]; p.conv_w = (const float*)d_in[9];
    p.memn_g = (const float*)d_in[10]; p.w_mk = (const float*)d_in[11]; p.w_mv = (const float*)d_in[12]; p.w_o = (const float*)d_in[13]; p.post_g = (const float*)d_in[14];
    p.out = (float*)d_out; p.ws = (unsigned char*)d_ws;
    for (int j = 0; j < 32; ++j) p.inv_freq[j] = 1.0f / powf(10000.0f, (float)(2 * j) / 64.0f);
#if MK_MULTI
    for (int ph = 0; ph < NPHASE; ++ph) { p.ph_lo = ph; p.ph_hi = ph + 1; hipLaunchKernelGGL(fwd_megakernel, dim3(grid), dim3(512), LDS_BYTES, stream, p); }
#else
    p.ph_lo = 0; p.ph_hi = NPHASE; void* args[] = {&p};
    hipError_t e = hipLaunchCooperativeKernel((const void*)fwd_megakernel, dim3(grid), dim3(512), args, LDS_BYTES, stream);
    if (e != hipSuccess) fprintf(stderr, "kernel_launch: cooperative launch failed: %s (grid %d)\n", hipGetErrorString(e), grid);
#endif
}
static_assert(att::LDS_BYTES <= LDS_MAIN, "attention LDS");
```
